# Optimizing an MI355X kernel written in HIP

```python
import jax, jax.numpy as jnp
from jax import lax
import numpy as np

D_MODEL = 1024
BATCH = 8
SEQ = 4096
DEPTH = 1

N_META = 16
D_MIX = D_MODEL
D_RG = D_MIX // 2
RG_HEADS = 8
RG_HEAD_DIM = D_RG // RG_HEADS
CONV_W = 4
LRU_C = 8.0
D_HG = D_MIX - D_RG
HG_HEAD_DIM = 128
HG_HEADS = D_HG // HG_HEAD_DIM
HG_CHUNK = 64
D_IN = 2 * D_RG + 4 * D_HG
D_FF = ((8 * D_MODEL // 3 + 255) // 256) * 256
EPS = 1e-6

kernel_name = "hymba_rglru_hgrn2_block"


def rmsnorm(x, g):
    xf = x.astype(jnp.float32)
    y = xf * lax.rsqrt(jnp.mean(xf * xf, axis=-1, keepdims=True) + EPS) * g.astype(jnp.float32)
    return y.astype(x.dtype)


def _lin_combine(e1, e2):
    a1, b1 = e1
    a2, b2 = e2
    return a1 * a2, a2 * b1 + b2


def rg_lru_group(xr, gr, conv_w, conv_b, w_r, b_r, w_i, b_i, lam, norm_g):
    B, L, _ = xr.shape
    xp = jnp.pad(xr.astype(jnp.float32), ((0, 0), (CONV_W - 1, 0), (0, 0)))
    cw = conv_w.astype(jnp.float32)
    xc = conv_b.astype(jnp.float32) + sum(xp[:, j:j + L] * cw[j] for j in range(CONV_W))
    xh = xc.reshape(B, L, RG_HEADS, RG_HEAD_DIM)
    r = jax.nn.sigmoid(jnp.einsum('blhi,hij->blhj', xh, w_r.astype(jnp.float32)).reshape(B, L, D_RG) + b_r.astype(jnp.float32))
    i = jax.nn.sigmoid(jnp.einsum('blhi,hij->blhj', xh, w_i.astype(jnp.float32)).reshape(B, L, D_RG) + b_i.astype(jnp.float32))
    log_a = -LRU_C * jax.nn.softplus(-lam.astype(jnp.float32)) * r
    a = jnp.exp(log_a)
    bx = jnp.sqrt(-jnp.expm1(2.0 * log_a)) * (i * xc)
    _, h = lax.associative_scan(_lin_combine, (a, bx), axis=1)
    y = jax.nn.gelu(gr.astype(jnp.float32)) * h
    return rmsnorm(y, norm_g)


def _to_chunks(t, pad):
    B, L, _ = t.shape
    t = jnp.pad(t, ((0, 0), (pad, 0), (0, 0)))
    n = (L + pad) // HG_CHUNK
    t = t.reshape(B, n, HG_CHUNK, HG_HEADS, HG_HEAD_DIM)
    return jnp.transpose(t, (1, 0, 3, 2, 4))


def _hgrn2_chunk_step(S, inp):
    q, k, v, lf = inp
    b = jnp.cumsum(lf, axis=2)
    inter = jnp.einsum('bhck,bhkv->bhcv', q * jnp.exp(b), S)
    diff = b[:, :, :, None, :] - b[:, :, None, :, :]
    causal = (jnp.arange(HG_CHUNK)[:, None] >= jnp.arange(HG_CHUNK)[None, :])[None, None, :, :, None]
    decay = jnp.where(causal, jnp.exp(jnp.where(causal, diff, 0.0)), 0.0)
    A = jnp.einsum('bhtsk,bhsk->bhts', q[:, :, :, None, :] * decay, k)
    intra = jnp.einsum('bhts,bhsv->bhtv', A, v)
    b_last = b[:, :, -1:, :]
    S_new = jnp.exp(b_last[:, :, 0, :])[..., None] * S + jnp.einsum('bhsk,bhsv->bhkv', k * jnp.exp(b_last - b), v)
    return S_new, inter + intra


def hgrn2_group(hq, hf, hi, hg, lb, norm_g):
    B, L, _ = hq.shape
    lb = lb.astype(jnp.float32)
    q = jax.nn.silu(hq.astype(jnp.float32))
    f = lb + (1.0 - lb) * jax.nn.sigmoid(hf.astype(jnp.float32))
    log_f = jnp.log(f)
    k = 1.0 - f
    v = hi.astype(jnp.float32)
    pad = HG_CHUNK - N_META
    qc, kc, vc, lfc = (_to_chunks(t, pad) for t in (q, k, v, log_f))
    S0 = jnp.zeros((B, HG_HEADS, HG_HEAD_DIM, HG_HEAD_DIM), jnp.float32)
    _, o = lax.scan(_hgrn2_chunk_step, S0, (qc, kc, vc, lfc))
    n = o.shape[0]
    o = jnp.transpose(o, (1, 0, 3, 2, 4)).reshape(B, n * HG_CHUNK, HG_HEADS, HG_HEAD_DIM)[:, pad:]
    o = rmsnorm(o, norm_g).astype(jnp.float32) * jax.nn.silu(hg.astype(jnp.float32).reshape(B, L, HG_HEADS, HG_HEAD_DIM))
    return o.reshape(B, L, D_HG)


def setup_inputs(seed: int = 0) -> dict:
    key = jax.random.key(seed)
    ks = jax.random.split(key, 24)
    f32 = jnp.float32
    nrm = lambda k, shape, s: s * jax.random.normal(k, shape, f32)
    u = jax.random.uniform(ks[9], (DEPTH, D_RG), f32, 0.9, 0.999)
    s = u ** (1.0 / LRU_C)
    lru_lambda = jnp.log(s) - jnp.log1p(-s)
    return {
        "x": jax.random.normal(ks[0], (BATCH, SEQ, D_MODEL), f32),
        "meta_tokens": nrm(ks[1], (N_META, D_MODEL), 1.0),
        "mix_norm_g": 1.0 + nrm(ks[2], (DEPTH, D_MODEL), 0.02),
        "w_in": nrm(ks[3], (DEPTH, D_MODEL, D_IN), D_MODEL ** -0.5),
        "conv_w": nrm(ks[4], (DEPTH, CONV_W, D_RG), CONV_W ** -0.5),
        "conv_b": nrm(ks[5], (DEPTH, D_RG), 0.01),
        "w_rgate": nrm(ks[6], (DEPTH, RG_HEADS, RG_HEAD_DIM, RG_HEAD_DIM), RG_HEAD_DIM ** -0.5),
        "b_rgate": nrm(ks[7], (DEPTH, D_RG), 0.01),
        "w_igate": nrm(ks[8], (DEPTH, RG_HEADS, RG_HEAD_DIM, RG_HEAD_DIM), RG_HEAD_DIM ** -0.5),
        "b_igate": nrm(ks[10], (DEPTH, D_RG), 0.01),
        "lru_lambda": lru_lambda,
        "rg_norm_g": 1.0 + nrm(ks[11], (DEPTH, D_RG), 0.02),
        "hg_lower_bound": nrm(ks[12], (DEPTH + 1, D_HG), 0.1),
        "hg_norm_g": 1.0 + nrm(ks[13], (DEPTH, HG_HEAD_DIM), 0.02),
        "w_out": nrm(ks[14], (DEPTH, D_MIX, D_MODEL), D_MIX ** -0.5),
        "ffn_norm_g": 1.0 + nrm(ks[15], (DEPTH, D_MODEL), 0.02),
        "w_gate_up": nrm(ks[16], (DEPTH, D_MODEL, 2 * D_FF), D_MODEL ** -0.5),
        "w_down": nrm(ks[17], (DEPTH, D_FF, D_MODEL), D_FF ** -0.5),
        "final_norm_g": 1.0 + nrm(ks[18], (D_MODEL,), 0.02),
    }


def reference(x, meta_tokens, mix_norm_g, w_in, conv_w, conv_b, w_rgate, b_rgate, w_igate, b_igate,
              lru_lambda, rg_norm_g, hg_lower_bound, hg_norm_g, w_out, ffn_norm_g, w_gate_up, w_down,
              final_norm_g):
    B = x.shape[0]
    meta = jnp.broadcast_to(meta_tokens.astype(x.dtype)[None], (B, N_META, D_MODEL))
    h = jnp.concatenate([meta, x], axis=1)
    lbs = jnp.cumsum(jax.nn.softmax(hg_lower_bound.astype(jnp.float32), axis=0), axis=0)
    splits = np.cumsum([D_RG, D_RG, D_HG, D_HG, D_HG])
    for l in range(DEPTH):
        u = rmsnorm(h, mix_norm_g[l])
        p = jnp.einsum('bld,de->ble', u, w_in[l])
        rg_x, rg_g, hq, hf, hi, hg = jnp.split(p, splits, axis=-1)
        y_rg = rg_lru_group(rg_x, rg_g, conv_w[l], conv_b[l], w_rgate[l], b_rgate[l],
                            w_igate[l], b_igate[l], lru_lambda[l], rg_norm_g[l])
        y_hg = hgrn2_group(hq, hf, hi, hg, lbs[l], hg_norm_g[l])
        y = jnp.concatenate([y_rg.astype(h.dtype), y_hg.astype(h.dtype)], axis=-1)
        h = h + jnp.einsum('ble,ed->bld', y, w_out[l])
        v = rmsnorm(h, ffn_norm_g[l])
        gate, up = jnp.split(jnp.einsum('bld,df->blf', v, w_gate_up[l]), 2, axis=-1)
        h = h + jnp.einsum('blf,fd->bld', jax.nn.silu(gate) * up, w_down[l])
    return rmsnorm(h, final_norm_g)[:, N_META:]
```

```cpp
#include <hip/hip_runtime.h>
#include <hip/hip_cooperative_groups.h>
#include <cstdio>
#include <cstdint>
namespace cg = cooperative_groups;
namespace pg8 {
#define PG8_LAS __attribute__((address_space(3)))
typedef unsigned short bf16_t;
typedef short bf16x8 __attribute__((ext_vector_type(8)));
typedef float f32x4 __attribute__((ext_vector_type(4)));
typedef unsigned u32x4 __attribute__((ext_vector_type(4)));
constexpr int BM = 256, BK = 64, HALF = 128, HTB = HALF * BK * 2  , STAGE_BYTES = 8 * HTB, NXCD = 8, WGM = 8;

__host__ __device__ __forceinline__ int lds_byte(int r, int c) { const int st = (r >> 4) * 2 + (c >> 5), rr = r & 15, cc = c & 31, ob = rr * 64 + cc * 2; return st * 1024 + (ob ^ (((ob >> 9) & 1) << 5)); }
__host__ __device__ __forceinline__ void stage_rc(int b, int& R, int& C) { const int st = b / 1024, sb = b % 1024, swz = sb ^ (((sb >> 9) & 1) << 5); R = (st >> 1) * 16 + swz / 64; C = (st & 1) * 32 + (swz % 64) / 2; }
__host__ __device__ __forceinline__ int perm32(int rho) { const int n = rho >> 4, i = rho & 15; return 8 * (i >> 2) + 4 * n + (i & 3); }

struct Unit { int pm, pn; };
struct Gemm { const bf16_t* A; const bf16_t* Bt; int M, N, K; };

struct StaticOrder {
    int nM, nN, nwg, G, c;
    __host__ __device__ void init(int M, int N, int G_, int c_) { nM = M / BM; nN = N / BM; nwg = nM * nN; G = G_; c = c_; }
    __host__ __device__ bool next(int i, Unit& u) const {
        const long L = (long)i * G + c; if (L >= nwg) return false;
        int wgid = (int)L; { const int q = nwg / NXCD, r = nwg % NXCD, xcd = wgid % NXCD, off = wgid / NXCD; wgid = (xcd < r ? xcd * (q + 1) : r * (q + 1) + (xcd - r) * q) + off; }
        const int nig = WGM * nN, gid = wgid / nig, fm = gid * WGM, gsz = (nM - fm) < WGM ? (nM - fm) : WGM;
        u.pm = fm + ((wgid % nig) % gsz); u.pn = (wgid % nig) / gsz; return true;
    }
    __device__ __forceinline__ void a_ready(const Unit&) const {}
    __device__ __forceinline__ void done(const Unit&) const {}
};

__device__ __forceinline__ unsigned cvt_pk_bf16(float lo, float hi) { unsigned r; asm volatile("v_cvt_pk_bf16_f32 %0, %1, %2" : "=v"(r) : "v"(lo), "v"(hi)); return r; }
typedef unsigned u32x2 __attribute__((ext_vector_type(2)));
struct EpiP {
    static constexpr bool PERM = true, AFTER_DRAIN = false;
    bf16_t* O; int ldc;
    __device__ __forceinline__ void operator()(const f32x4 (&acc)[2][2][4][2], const Unit& u, int wr, int wc, int fr, int fq) const {
        const int row0 = u.pm * BM + wr * 64 + fr, col0 = u.pn * BM + wc * 32 + 8 * fq;
#pragma unroll
        for (int ai = 0; ai < 2; ++ai)
#pragma unroll
            for (int m = 0; m < 4; ++m) { bf16_t* rowp = O + (size_t)(row0 + ai * HALF + m * 16) * ldc + col0;
#pragma unroll
                for (int bj = 0; bj < 2; ++bj) { const f32x4 v0 = acc[ai][bj][m][0], v1 = acc[ai][bj][m][1];
                    u32x4 w; w.x = cvt_pk_bf16(v0[0], v0[1]); w.y = cvt_pk_bf16(v0[2], v0[3]); w.z = cvt_pk_bf16(v1[0], v1[1]); w.w = cvt_pk_bf16(v1[2], v1[3]);
                    *(u32x4*)(rowp + bj * HALF) = w; } }
    }
};
struct EpiOut {
    static constexpr bool PERM = false, AFTER_DRAIN = false;
    const float* x; float* out; bf16_t* hb; float* ssq;
    __device__ __forceinline__ void operator()(const f32x4 (&acc)[2][2][4][2], const Unit& u, int wr, int wc, int fr, int fq) const {
        const int row0 = u.pm * BM + wr * 64 + fr, col0 = u.pn * BM + wc * 32 + 4 * fq;
#pragma unroll
        for (int ai = 0; ai < 2; ++ai)
#pragma unroll
            for (int m = 0; m < 4; ++m) { const int row = row0 + ai * HALF + m * 16; const size_t off = (size_t)row * 1024 + col0; float s = 0.f;
#pragma unroll
                for (int bj = 0; bj < 2; ++bj)
#pragma unroll
                    for (int n = 0; n < 2; ++n) { const size_t o = off + bj * HALF + n * 16; const f32x4 xv = *(const f32x4*)(x + o); const f32x4 hv = xv + acc[ai][bj][m][n];
                        *(f32x4*)(out + o) = hv; s += (hv[0] * hv[0] + hv[1] * hv[1]) + (hv[2] * hv[2] + hv[3] * hv[3]);
                        u32x2 w; w.x = cvt_pk_bf16(hv[0], hv[1]); w.y = cvt_pk_bf16(hv[2], hv[3]); *(u32x2*)(hb + o) = w; }
                s += __shfl_xor(s, 16); s += __shfl_xor(s, 32);
                if (fq == 0) ssq[(size_t)row * 16 + u.pn * 4 + wc] = s; }
    }
};
struct EpiGU {
    static constexpr bool PERM = true, AFTER_DRAIN = false;
    const float* ssq; bf16_t* act;
    __device__ __forceinline__ void operator()(const f32x4 (&acc)[2][2][4][2], const Unit& u, int wr, int wc, int fr, int fq) const {
        const int row0 = u.pm * BM + wr * 64 + fr, col0 = u.pn * 128 + wc * 32 + 8 * fq;
#pragma unroll
        for (int ai = 0; ai < 2; ++ai)
#pragma unroll
            for (int m = 0; m < 4; ++m) { const int row = row0 + ai * HALF + m * 16; const f32x4* sp = (const f32x4*)(ssq + (size_t)row * 16);
                const f32x4 s0 = sp[0], s1 = sp[1], s2 = sp[2], s3 = sp[3]; const f32x4 st = (s0 + s1) + (s2 + s3);
                const float rinv = rsqrtf(((st[0] + st[1]) + (st[2] + st[3])) * (1.0f / 1024.0f) + 1e-6f);
                float a[8];
#pragma unroll
                for (int n = 0; n < 2; ++n)
#pragma unroll
                    for (int j = 0; j < 4; ++j) { const float g = acc[ai][0][m][n][j] * rinv, up = acc[ai][1][m][n][j] * rinv; a[4 * n + j] = g * __builtin_amdgcn_rcpf(1.0f + __expf(-g)) * up; }
                u32x4 w; w.x = cvt_pk_bf16(a[0], a[1]); w.y = cvt_pk_bf16(a[2], a[3]); w.z = cvt_pk_bf16(a[4], a[5]); w.w = cvt_pk_bf16(a[6], a[7]);
                *(u32x4*)(act + (size_t)row * 2816 + col0) = w; }
    }
};
struct EpiDown {
    static constexpr bool PERM = false, AFTER_DRAIN = false;
    float* out; float* ssq;
    __device__ __forceinline__ void operator()(const f32x4 (&acc)[2][2][4][2], const Unit& u, int wr, int wc, int fr, int fq) const {
        const int row0 = u.pm * BM + wr * 64 + fr, col0 = u.pn * BM + wc * 32 + 4 * fq;
#pragma unroll
        for (int ai = 0; ai < 2; ++ai)
#pragma unroll
            for (int m = 0; m < 4; ++m) { const int row = row0 + ai * HALF + m * 16; const size_t off = (size_t)row * 1024 + col0; float s = 0.f;
#pragma unroll
                for (int bj = 0; bj < 2; ++bj)
#pragma unroll
                    for (int n = 0; n < 2; ++n) { const size_t o = off + bj * HALF + n * 16; const f32x4 xv = *(const f32x4*)(out + o); const f32x4 hv = xv + acc[ai][bj][m][n];
                        *(f32x4*)(out + o) = hv; s += (hv[0] * hv[0] + hv[1] * hv[1]) + (hv[2] * hv[2] + hv[3] * hv[3]); }
                s += __shfl_xor(s, 16); s += __shfl_xor(s, 32);
                if (fq == 0) ssq[(size_t)row * 16 + u.pn * 4 + wc] = s; }
    }
};
template <class Epi, class Sched, bool ALIGN_EPI = false, bool SP2 = false>
__device__ __forceinline__ void gemm_phase(PG8_LAS unsigned char* lds, const Gemm g, const Sched& S, const Epi& E) {
    const int tid = threadIdx.x, wid = __builtin_amdgcn_readfirstlane(tid >> 6), lane = tid & 63, wr = wid >> 2, wc = wid & 3, fr = lane & 15, fq = lane >> 4;
    const int K = g.K, nt = K / BK;
    unsigned voffA[2], voffB[2];
#pragma unroll
    for (int i = 0; i < 2; ++i) { int R, C; stage_rc(tid * 16 + i * 8192, R, C); const int Rb = Epi::PERM ? ((R & ~31) + perm32(R & 31)) : R;
        voffA[i] = (unsigned)(R * K + C) * 2u; voffB[i] = (unsigned)(Rb * K + C) * 2u; }
    const size_t kstep = (size_t)(BK * 2);
    const size_t hstep = (size_t)HALF * K * 2;
    const size_t tstep = 2 * hstep;
    const unsigned ldsw = (unsigned)wid * 1024u;
    const int aoff = lds_byte(wr * 64 + fr, fq * 8), boff = lds_byte(wc * 32 + fr, fq * 8);
#define PG8_SA(b, h) (((b) * 2 + (h)) * HTB)
#define PG8_SB(b, h) ((4 + (b) * 2 + (h)) * HTB)
#define PG8_STAGE(bufoff, gbase, voff) do { _Pragma("unroll") for (int _i = 0; _i < 2; ++_i) \
        __builtin_amdgcn_global_load_lds((const unsigned*)((const char*)(gbase) + (voff)[_i]), (PG8_LAS unsigned*)(lds + (bufoff) + ldsw + _i * 8192), 16, 0, 0); } while (0)
#define PG8_LDA(dst, b, h) do { _Pragma("unroll") for (int m = 0; m < 4; ++m) _Pragma("unroll") for (int k = 0; k < 2; ++k) dst[m][k] = *(const PG8_LAS bf16x8*)(lds + PG8_SA(b, h) + aoff + m * 2048 + k * 1024); } while (0)
#define PG8_LDB(dst, b, h) do { _Pragma("unroll") for (int n = 0; n < 2; ++n) _Pragma("unroll") for (int k = 0; k < 2; ++k) dst[n][k] = *(const PG8_LAS bf16x8*)(lds + PG8_SB(b, h) + boff + n * 2048 + k * 1024); } while (0)
#define PG8_MMA(ai, bj, At, Bt) do { __builtin_amdgcn_s_setprio(1); _Pragma("unroll") for (int m = 0; m < 4; ++m) _Pragma("unroll") for (int n = 0; n < 2; ++n) _Pragma("unroll") for (int k = 0; k < 2; ++k) \
        acc[ai][bj][m][n] = __builtin_amdgcn_mfma_f32_16x16x32_bf16(Bt[n][k], At[m][k], acc[ai][bj][m][n], 0, 0, 0); __builtin_amdgcn_s_setprio(0); } while (0)
#define PG8_WAIT_V(n) asm volatile("s_waitcnt vmcnt(" #n ")" ::: "memory")
#define PG8_WAIT_L(n) asm volatile("s_waitcnt lgkmcnt(" #n ")" ::: "memory")
#define PG8_BAR __builtin_amdgcn_s_barrier()
#define PG8_SCHED __builtin_amdgcn_sched_barrier(0)
    Unit cur, nxt; int ui = 0;
    if (!S.next(0, cur)) return;
    f32x4 acc[2][2][4][2];
#pragma unroll
    for (int a = 0; a < 2; ++a)
#pragma unroll
        for (int b = 0; b < 2; ++b)
#pragma unroll
            for (int m = 0; m < 4; ++m)
#pragma unroll
                for (int n = 0; n < 2; ++n) acc[a][b][m][n] = (f32x4){0.f, 0.f, 0.f, 0.f};
    bf16x8 At[4][2], B0[2][2], B1[2][2];
    const char* cA = (const char*)g.A + (size_t)cur.pm * tstep; const char* cB = (const char*)g.Bt + (size_t)cur.pn * tstep;
    S.a_ready(cur);
    if constexpr (SP2) {
        PG8_STAGE(PG8_SB(0, 0), cB, voffB); PG8_STAGE(PG8_SB(0, 1), cB + hstep, voffB); PG8_STAGE(PG8_SA(0, 0), cA, voffA); PG8_STAGE(PG8_SA(0, 1), cA + hstep, voffA);
        if (wr == 1) PG8_BAR;
        PG8_WAIT_V(2); PG8_BAR;
        PG8_STAGE(PG8_SB(1, 0), cB + kstep, voffB); PG8_STAGE(PG8_SA(1, 0), cA + kstep, voffA); PG8_STAGE(PG8_SB(1, 1), cB + hstep + kstep, voffB);
        PG8_WAIT_V(6); PG8_BAR;
    } else {
        PG8_STAGE(PG8_SB(0, 0), cB, voffB); PG8_STAGE(PG8_SA(0, 0), cA, voffA); PG8_STAGE(PG8_SB(0, 1), cB + hstep, voffB); PG8_STAGE(PG8_SA(0, 1), cA + hstep, voffA);
        if (wr == 1) PG8_BAR;
        PG8_WAIT_V(4); PG8_BAR;
        PG8_STAGE(PG8_SB(1, 0), cB + kstep, voffB); PG8_STAGE(PG8_SA(1, 0), cA + kstep, voffA); PG8_STAGE(PG8_SB(1, 1), cB + hstep + kstep, voffB);
        PG8_WAIT_V(6); PG8_BAR;
    }
    for (;;) {
        const bool has_next = S.next(ui + 1, nxt);
        const char* nA = has_next ? (const char*)g.A + (size_t)nxt.pm * tstep : cA; const char* nB = has_next ? (const char*)g.Bt + (size_t)nxt.pn * tstep : cB;
        for (int t = 0; t < nt; t += 2) {
            const bool last = (t == nt - 2);
            const char* a1 = cA + (size_t)(t + 1) * kstep;
            const char* a2 = last ? nA : cA + (size_t)(t + 2) * kstep; const char* b2 = last ? nB : cB + (size_t)(t + 2) * kstep;
            const char* a3 = a2 + kstep; const char* b3 = b2 + kstep;
            if (last && has_next) S.a_ready(nxt);
            if constexpr (SP2) {
            PG8_LDB(B0, 0, 0); PG8_LDB(B1, 0, 1); PG8_SCHED; PG8_LDA(At, 0, 0); PG8_STAGE(PG8_SA(1, 1), a1 + hstep, voffA);
            PG8_WAIT_V(8); PG8_WAIT_L(0); PG8_BAR; PG8_MMA(0, 0, At, B0); PG8_MMA(0, 1, At, B1); PG8_BAR; PG8_SCHED;
            PG8_LDA(At, 0, 1); PG8_STAGE(PG8_SB(0, 0), b2, voffB); PG8_STAGE(PG8_SB(0, 1), b2 + hstep, voffB); PG8_STAGE(PG8_SA(0, 0), a2, voffA);
            PG8_WAIT_V(8); PG8_WAIT_L(0); PG8_BAR; PG8_MMA(1, 0, At, B0); PG8_MMA(1, 1, At, B1); PG8_BAR; PG8_SCHED;
            PG8_LDB(B0, 1, 0); PG8_LDB(B1, 1, 1); PG8_SCHED; PG8_LDA(At, 1, 0); PG8_STAGE(PG8_SA(0, 1), a2 + hstep, voffA);
            PG8_WAIT_V(8); PG8_WAIT_L(0); PG8_BAR; PG8_MMA(0, 0, At, B0); PG8_MMA(0, 1, At, B1); PG8_BAR; PG8_SCHED;
            PG8_LDA(At, 1, 1); PG8_STAGE(PG8_SB(1, 0), b3, voffB); PG8_STAGE(PG8_SB(1, 1), b3 + hstep, voffB); PG8_STAGE(PG8_SA(1, 0), a3, voffA);
            PG8_WAIT_V(8); PG8_WAIT_L(0); PG8_BAR; PG8_MMA(1, 0, At, B0); PG8_MMA(1, 1, At, B1); PG8_BAR; PG8_SCHED;
            } else {
            PG8_LDB(B0, 0, 0); PG8_SCHED; PG8_LDA(At, 0, 0); PG8_STAGE(PG8_SA(1, 1), a1 + hstep, voffA);
            PG8_WAIT_L(8); PG8_BAR; PG8_WAIT_L(0); PG8_MMA(0, 0, At, B0); PG8_BAR; PG8_SCHED;
            PG8_LDB(B1, 0, 1); PG8_STAGE(PG8_SB(0, 0), b2, voffB);
            PG8_BAR; PG8_WAIT_L(0); PG8_MMA(0, 1, At, B1); PG8_BAR;
            PG8_LDA(At, 0, 1); PG8_STAGE(PG8_SA(0, 0), a2, voffA);
            PG8_BAR; PG8_WAIT_L(0); PG8_MMA(1, 0, At, B0); PG8_BAR; PG8_SCHED;
            PG8_STAGE(PG8_SB(0, 1), b2 + hstep, voffB);
            PG8_WAIT_V(6); PG8_BAR; PG8_MMA(1, 1, At, B1); PG8_BAR;
            PG8_LDB(B0, 1, 0); PG8_SCHED; PG8_LDA(At, 1, 0); PG8_STAGE(PG8_SA(0, 1), a2 + hstep, voffA);
            PG8_WAIT_L(8); PG8_BAR; PG8_WAIT_L(0); PG8_MMA(0, 0, At, B0); PG8_BAR; PG8_SCHED;
            PG8_LDB(B1, 1, 1); PG8_STAGE(PG8_SB(1, 0), b3, voffB);
            PG8_BAR; PG8_WAIT_L(0); PG8_MMA(0, 1, At, B1); PG8_BAR;
            PG8_LDA(At, 1, 1); PG8_STAGE(PG8_SA(1, 0), a3, voffA);
            PG8_BAR; PG8_WAIT_L(0); PG8_MMA(1, 0, At, B0); PG8_BAR; PG8_SCHED;
            PG8_STAGE(PG8_SB(1, 1), b3 + hstep, voffB);
            PG8_WAIT_V(6); PG8_BAR; PG8_MMA(1, 1, At, B1); PG8_BAR;
            }
        }
        if constexpr (ALIGN_EPI) { if (wr == 0) PG8_BAR; }
        if constexpr (!Epi::AFTER_DRAIN) { E(acc, cur, wr, wc, fr, fq); S.done(cur); }
        if (!has_next) break;
#pragma unroll
        for (int a = 0; a < 2; ++a)
#pragma unroll
            for (int b = 0; b < 2; ++b)
#pragma unroll
                for (int m = 0; m < 4; ++m)
#pragma unroll
                    for (int n = 0; n < 2; ++n) acc[a][b][m][n] = (f32x4){0.f, 0.f, 0.f, 0.f};
        cur = nxt; cA = nA; cB = nB; ++ui;
        if constexpr (ALIGN_EPI) { if (wr == 1) PG8_BAR; }
    }
    PG8_WAIT_V(0);
    if constexpr (!ALIGN_EPI) { if (wr == 0) PG8_BAR; }
    PG8_BAR;
    if constexpr (Epi::AFTER_DRAIN) { E.fused(acc, cur, wr, wc, fr, fq, lds, wid, lane); S.done(cur); }
#undef PG8_SA
#undef PG8_SB
#undef PG8_STAGE
#undef PG8_LDA
#undef PG8_LDB
#undef PG8_MMA
#undef PG8_WAIT_V
#undef PG8_WAIT_L
#undef PG8_BAR
#undef PG8_SCHED
}
}

#ifndef MK_N_LAUNCHES
#define MK_N_LAUNCHES 1
#endif
#ifndef SKIPMASK
#define SKIPMASK 0
#endif
constexpr int NPH = 8;
constexpr int NB = 8, SEQ = 4096, DM = 1024, NMETA = 16, DIN = 3072, DRG = 512, DFF = 2816;
constexpr int MROWS = NB * SEQ;
constexpr float EPS = 1e-6f;
constexpr size_t MiB = 1u << 20;
constexpr size_t WS_WIN = 0, WS_WO = 6 * MiB, WS_WGU = 8 * MiB, WS_WD = 19 * MiB, WS_WG = 25 * MiB;
constexpr size_t WS_RGA = 26 * MiB, WS_RGH = 26 * MiB + 512 * 1024, WS_HM = 27 * MiB, WS_BT = 27 * MiB + 64 * 1024, WS_SM = 28 * MiB;
constexpr size_t WS_SSQ1 = 30 * MiB, WS_SSQ2 = 32 * MiB, WS_SL = 34 * MiB;
constexpr size_t WS_XN = 64 * MiB;
constexpr size_t WS_Y = 128 * MiB;
constexpr size_t WS_P = 192 * MiB;
constexpr size_t WS_END = 392 * MiB;
constexpr int LDS_BYTES = 147456;

#define LAS __attribute__((address_space(3)))
typedef unsigned short bf16;
typedef float f32x4 __attribute__((ext_vector_type(4)));
typedef short bf16x8 __attribute__((ext_vector_type(8)));
typedef unsigned v4u __attribute__((ext_vector_type(4)));
typedef unsigned v2u __attribute__((ext_vector_type(2)));
__device__ __forceinline__ float bf2f(unsigned short b) { return __uint_as_float(((unsigned)b) << 16); }
__device__ __forceinline__ unsigned f2bf(float f) { unsigned u = __float_as_uint(f); return (u + 0x7fffu + ((u >> 16) & 1u)) >> 16; }
__device__ __forceinline__ unsigned pk2(float lo, float hi) { return f2bf(lo) | (f2bf(hi) << 16); }
__device__ __forceinline__ float sigm(float x) { return __builtin_amdgcn_rcpf(1.0f + __expf(-x)); }
__device__ __forceinline__ float wave_sum(float v) {
#pragma unroll
    for (int o = 1; o < 64; o <<= 1) v += __shfl_xor(v, o);
    return v;
}
#define MFMA16(a, b, c) __builtin_amdgcn_mfma_f32_16x16x32_bf16((a), (b), (c), 0, 0, 0)

__device__ __forceinline__ void p0_transpose_item(const float* W, int K, int N, bf16* WT, LAS float* scr, int item, int lane, int mode, const float* ksc) {
    const int nblk = N / 32, kb = item / nblk, nb = item % nblk, k0 = 64 * kb, n0 = 32 * nb;
    int src0 = n0;
    if (mode == 1) { const int t = n0 >> 8, c = n0 & 255; src0 = (c < 128) ? (t * 128 + c) : (DFF + t * 128 + (c - 128)); }
#pragma unroll 8
    for (int i = 0; i < 32; ++i) { const int kk = 2 * i + (lane >> 5); float v = W[(size_t)(k0 + kk) * N + src0 + (lane & 31)]; if (mode == 1) v *= ksc[k0 + kk]; scr[kk * 33 + (lane & 31)] = v; }
    asm volatile("s_waitcnt lgkmcnt(0)" ::: "memory");
    const int c = lane & 7;
#pragma unroll
    for (int j = 0; j < 4; ++j) { const int n = (lane >> 3) + 8 * j; const LAS float* s = scr + (8 * c) * 33 + n;
        v4u o; o.x = pk2(s[0 * 33], s[1 * 33]); o.y = pk2(s[2 * 33], s[3 * 33]); o.z = pk2(s[4 * 33], s[5 * 33]); o.w = pk2(s[6 * 33], s[7 * 33]);
        *(v4u*)(WT + (size_t)(n0 + n) * K + k0 + 8 * c) = o; }
    asm volatile("s_waitcnt lgkmcnt(0)" ::: "memory");
}
__device__ __forceinline__ void rms_row_to_bf16(const float* xrow, const float* g, bf16* orow, int lane) {
    const f32x4* xr = (const f32x4*)xrow + lane; const f32x4* gr = (const f32x4*)g + lane;
    f32x4 v[4]; float s = 0.f;
#pragma unroll
    for (int j = 0; j < 4; ++j) { v[j] = xr[64 * j]; s += (v[j].x * v[j].x + v[j].y * v[j].y) + (v[j].z * v[j].z + v[j].w * v[j].w); }
    const float rinv = rsqrtf(wave_sum(s) * (1.f / DM) + EPS);
    unsigned long long* o8 = (unsigned long long*)orow + lane;
#pragma unroll
    for (int j = 0; j < 4; ++j) { const f32x4 gg = gr[64 * j];
        o8[64 * j] = (unsigned long long)pk2(v[j].x * rinv * gg.x, v[j].y * rinv * gg.y) | ((unsigned long long)pk2(v[j].z * rinv * gg.z, v[j].w * rinv * gg.w) << 32); }
}

constexpr int RG_WAVE_LDS = 10496, RG_SSQ_OFF = 8 * RG_WAVE_LDS;
template <bool FINAL>
__device__ __forceinline__ void rg_run(LAS unsigned char* lds, const bf16* P, const bf16* Wg, const float* conv_w, const float* conv_b, const float* b_r, const float* b_i, const float* lam,
                                       const float* gnorm, float* Aseg, float* Hseg, float* hmeta, bf16* Y, int b, int seg, bool is_meta, int wave, int lane) {
    const int c = wave * 64 + lane;
    LAS bf16* xcb = (LAS bf16*)(lds + wave * RG_WAVE_LDS);
    LAS float* pre_r = (LAS float*)(lds + wave * RG_WAVE_LDS + 2304);
    LAS float* pre_i = pre_r + 1024;
    LAS float* ssql = (LAS float*)(lds + RG_SSQ_OFF);
    const float cw0 = conv_w[c], cw1 = conv_w[DRG + c], cw2 = conv_w[2 * DRG + c], cw3 = conv_w[3 * DRG + c], cb = conv_b[c];
    const float br = b_r[c], bi = b_i[c];
    const float sp = 8.0f * log1pf(__expf(-lam[c]));
    const float gn = FINAL ? gnorm[c] : 0.f;
    bf16x8 bw[2][4][2];
#pragma unroll
    for (int g = 0; g < 2; ++g)
#pragma unroll
        for (int nt = 0; nt < 4; ++nt)
#pragma unroll
            for (int ks = 0; ks < 2; ++ks) bw[g][nt][ks] = *(const bf16x8*)(Wg + ((size_t)(g * 8 + wave) * 64 + nt * 16 + (lane & 15)) * 64 + ks * 32 + (lane >> 4) * 8);
    float h = 0.f, pa = 1.f, xm3 = 0.f, xm2 = 0.f, xm1 = 0.f;
    const int nsb = is_meta ? 1 : 8;
    const size_t row0 = is_meta ? (size_t)MROWS : (size_t)b * SEQ + (size_t)seg * 128;
    if (!is_meta) {
        const size_t r3 = (seg == 0) ? (size_t)MROWS + 13 : row0 - 3;
        xm3 = bf2f(P[r3 * DIN + c]); xm2 = bf2f(P[(r3 + 1) * DIN + c]); xm1 = bf2f(P[(r3 + 2) * DIN + c]);
        if (FINAL) { h = hmeta[c]; for (int j = 0; j < seg; ++j) h = Aseg[(size_t)(b * 32 + j) * DRG + c] * h + Hseg[(size_t)(b * 32 + j) * DRG + c]; }
    }
    for (int sb = 0; sb < nsb; ++sb) {
        const size_t rb = row0 + (size_t)sb * 16;
        float e[19], gr[16], xc[16], yv[16];
        e[0] = xm3; e[1] = xm2; e[2] = xm1;
#pragma unroll
        for (int i = 0; i < 16; ++i) e[3 + i] = bf2f(P[(rb + i) * DIN + c]);
        if (FINAL) {
#pragma unroll
            for (int i = 0; i < 16; ++i) gr[i] = bf2f(P[(rb + i) * DIN + DRG + c]);
        }
        xm3 = e[16]; xm2 = e[17]; xm1 = e[18];
#pragma unroll
        for (int i = 0; i < 16; ++i) { xc[i] = cb + cw0 * e[i] + cw1 * e[i + 1] + cw2 * e[i + 2] + cw3 * e[i + 3]; xcb[i * 72 + lane] = (bf16)f2bf(xc[i]); }
        asm volatile("s_waitcnt lgkmcnt(0)" ::: "memory"); __builtin_amdgcn_wave_barrier();
        bf16x8 af[2];
#pragma unroll
        for (int ks = 0; ks < 2; ++ks) af[ks] = *(const LAS bf16x8*)(xcb + (lane & 15) * 72 + ks * 32 + (lane >> 4) * 8);
#pragma unroll
        for (int g = 0; g < 2; ++g)
#pragma unroll
            for (int nt = 0; nt < 4; ++nt) { f32x4 acc = {0.f, 0.f, 0.f, 0.f};
#pragma unroll
                for (int ks = 0; ks < 2; ++ks) acc = MFMA16(af[ks], bw[g][nt][ks], acc);
                LAS float* pre = g ? pre_i : pre_r;
#pragma unroll
                for (int j = 0; j < 4; ++j) pre[((lane >> 4) * 4 + j) * 64 + nt * 16 + (lane & 15)] = acc[j]; }
        asm volatile("s_waitcnt lgkmcnt(0)" ::: "memory"); __builtin_amdgcn_wave_barrier();
#pragma unroll
        for (int i = 0; i < 16; ++i) {
            const float r = sigm(pre_r[i * 64 + lane] + br), ig = sigm(pre_i[i * 64 + lane] + bi);
            const float la = -sp * r, a = __expf(la), mlt = sqrtf(-expm1f(2.0f * la));
            h = a * h + mlt * (ig * xc[i]);
            if (!FINAL) pa *= a;
            else { const float g = gr[i]; const float gl = g * sigm(1.5957691216f * (g + 0.044715f * g * g * g)); yv[i] = gl * h; }
        }
        asm volatile("s_waitcnt lgkmcnt(0)" ::: "memory"); __builtin_amdgcn_wave_barrier();
        if (FINAL) {
            LAS float* sq = ssql + (sb & 1) * 128;
            float mine = 0.f;
#pragma unroll
            for (int i = 0; i < 16; ++i) { const float s = wave_sum(yv[i] * yv[i]); mine = (lane == i) ? s : mine; }
            if (lane < 16) sq[wave * 16 + lane] = mine;
            __syncthreads();
            float tot = 0.f;
            if (lane < 16) {
#pragma unroll
                for (int w = 0; w < 8; ++w) tot += sq[w * 16 + lane]; }
            const float rl = rsqrtf(tot * (1.0f / DRG) + EPS);
#pragma unroll
            for (int i = 0; i < 16; ++i) { const float rinv = __shfl(rl, i); Y[(rb + i) * DM + c] = (bf16)f2bf(yv[i] * rinv * gn); }
        }
    }
    if (!FINAL) { if (is_meta) hmeta[c] = h; else { Aseg[(size_t)(b * 32 + seg) * DRG + c] = pa; Hseg[(size_t)(b * 32 + seg) * DRG + c] = h; } }
}

constexpr int HG_QT = 0, HG_KH = 17408, HG_KHT = 34816, HG_VT = 53248, HG_ST = 71680, HG_AM = 106496, HG_GS = 115712, HG_EB = 117760, HG_SQ = 118272;
template <bool FINAL>
__device__ __forceinline__ void hg_run(LAS unsigned char* lds, const bf16* P, const float* Lb, const float* gnorm, float* Sloc, float* Btot, float* Smeta, bf16* Y,
                                       int b, int h, int sc, bool is_meta, int tid, int wave, int lane) {
    LAS bf16* Qt = (LAS bf16*)(lds + HG_QT); LAS bf16* Kh = (LAS bf16*)(lds + HG_KH); LAS bf16* KhT = (LAS bf16*)(lds + HG_KHT); LAS bf16* VT = (LAS bf16*)(lds + HG_VT);
    LAS bf16* St = (LAS bf16*)(lds + HG_ST); LAS bf16* Am = (LAS bf16*)(lds + HG_AM); LAS float* gsum = (LAS float*)(lds + HG_GS); LAS float* eb = (LAS float*)(lds + HG_EB); LAS float* ssqp = (LAS float*)(lds + HG_SQ);
    const int g = tid >> 7, k = tid & 127, lr = lane & 15, lq = lane >> 4;
    const float lb = 1.0f / (1.0f + __expf(Lb[DRG + h * 128 + k] - Lb[h * 128 + k]));
    const int item = (b * 4 + h) * 8 + sc;
    f32x4 S[8];
#pragma unroll
    for (int tv = 0; tv < 8; ++tv) S[tv] = (f32x4){0.f, 0.f, 0.f, 0.f};
    if (FINAL) {
#pragma unroll
        for (int j = 0; j < 4; ++j) { const int kr = 16 * wave + 4 * lq + j;
#pragma unroll
            for (int tv = 0; tv < 8; ++tv) S[tv][j] = Smeta[(size_t)(h * 128 + kr) * 128 + 16 * tv + lr]; }
        for (int jj = 0; jj < sc; ++jj) { const int it = (b * 4 + h) * 8 + jj;
#pragma unroll
            for (int j = 0; j < 4; ++j) { const int kr = 16 * wave + 4 * lq + j; const float d = __expf(Btot[(size_t)it * 128 + kr]);
#pragma unroll
                for (int tv = 0; tv < 8; ++tv) S[tv][j] = d * S[tv][j] + Sloc[((size_t)it * 128 + kr) * 128 + 16 * tv + lr]; } }
#pragma unroll
        for (int tv = 0; tv < 8; ++tv) { v2u w; w.x = pk2(S[tv][0], S[tv][1]); w.y = pk2(S[tv][2], S[tv][3]); *(LAS v2u*)(St + (16 * tv + lr) * 136 + 16 * wave + 4 * lq) = w; }
    }
    float btot = 0.f;
    const int nch = is_meta ? 1 : 8, nvalid = is_meta ? NMETA : 64;
    for (int ch = 0; ch < nch; ++ch) {
        const size_t rowbase = is_meta ? (size_t)MROWS : (size_t)b * SEQ + (size_t)sc * 512 + (size_t)ch * 64;
        float lfc[16], kk[16], qv[16]; unsigned short vb[16]; float cum = 0.f;
#pragma unroll
        for (int i = 0; i < 16; ++i) { const int s = 16 * g + i; const bool valid = s < nvalid; const size_t row = rowbase + (valid ? s : 0); const bf16* pr = P + row * DIN + h * 128 + k;
            const float hf = bf2f(pr[1536]); const float f = lb + (1.0f - lb) * sigm(hf);
            const float lf = valid ? __logf(f) : 0.f; kk[i] = valid ? (1.0f - f) : 0.f; cum += lf; lfc[i] = cum;
            vb[i] = valid ? pr[2048] : (unsigned short)0;
            if (FINAL) { const float hq = bf2f(pr[1024]); qv[i] = hq * sigm(hq); } }
        gsum[g * 128 + k] = cum;
        __syncthreads();
        float pre = 0.f, tot = 0.f;
#pragma unroll
        for (int gg = 0; gg < 4; ++gg) { const float v = gsum[gg * 128 + k]; tot += v; pre += (gg < g) ? v : 0.f; }
        unsigned kp[8], vp[8];
#pragma unroll
        for (int i = 0; i < 16; i += 2) { const float b0 = pre + lfc[i], b1 = pre + lfc[i + 1];
            const unsigned k0 = f2bf(kk[i] * __expf(-b0)), k1 = f2bf(kk[i + 1] * __expf(-b1));
            kp[i >> 1] = k0 | (k1 << 16); vp[i >> 1] = (unsigned)vb[i] | ((unsigned)vb[i + 1] << 16);
            if (FINAL) { Kh[(16 * g + i) * 136 + k] = (bf16)k0; Kh[(16 * g + i + 1) * 136 + k] = (bf16)k1;
                Qt[(16 * g + i) * 136 + k] = (bf16)f2bf(qv[i] * __expf(b0)); Qt[(16 * g + i + 1) * 136 + k] = (bf16)f2bf(qv[i + 1] * __expf(b1)); } }
        *(LAS v4u*)(KhT + k * 72 + 16 * g) = (v4u){kp[0], kp[1], kp[2], kp[3]}; *(LAS v4u*)(KhT + k * 72 + 16 * g + 8) = (v4u){kp[4], kp[5], kp[6], kp[7]};
        *(LAS v4u*)(VT + k * 72 + 16 * g) = (v4u){vp[0], vp[1], vp[2], vp[3]}; *(LAS v4u*)(VT + k * 72 + 16 * g + 8) = (v4u){vp[4], vp[5], vp[6], vp[7]};
        if (g == 0) eb[k] = __expf(tot);
        btot += tot;
        __syncthreads();
        if (FINAL) {
            { const int tt = wave >> 1;
#pragma unroll
              for (int q = 0; q < 2; ++q) { const int ts = 2 * (wave & 1) + q; f32x4 acc = {0.f, 0.f, 0.f, 0.f};
#pragma unroll
                for (int ks = 0; ks < 4; ++ks) { const bf16x8 a = *(const LAS bf16x8*)(Qt + (16 * tt + lr) * 136 + ks * 32 + lq * 8); const bf16x8 bb = *(const LAS bf16x8*)(Kh + (16 * ts + lr) * 136 + ks * 32 + lq * 8); acc = MFMA16(a, bb, acc); }
#pragma unroll
                for (int j = 0; j < 4; ++j) { const int t = 16 * tt + 4 * lq + j, s = 16 * ts + lr; Am[t * 72 + s] = (bf16)f2bf((s <= t) ? acc[j] : 0.f); } } }
            __syncthreads();
            const int tt = wave & 3, vh = wave >> 2;
            f32x4 o[4];
#pragma unroll
            for (int q = 0; q < 4; ++q) o[q] = (f32x4){0.f, 0.f, 0.f, 0.f};
#pragma unroll
            for (int ks = 0; ks < 4; ++ks) { const bf16x8 a = *(const LAS bf16x8*)(Qt + (16 * tt + lr) * 136 + ks * 32 + lq * 8);
#pragma unroll
                for (int q = 0; q < 4; ++q) { const bf16x8 bb = *(const LAS bf16x8*)(St + (16 * (4 * vh + q) + lr) * 136 + ks * 32 + lq * 8); o[q] = MFMA16(a, bb, o[q]); } }
#pragma unroll
            for (int ks = 0; ks < 2; ++ks) { const bf16x8 a = *(const LAS bf16x8*)(Am + (16 * tt + lr) * 72 + ks * 32 + lq * 8);
#pragma unroll
                for (int q = 0; q < 4; ++q) { const bf16x8 bb = *(const LAS bf16x8*)(VT + (16 * (4 * vh + q) + lr) * 72 + ks * 32 + lq * 8); o[q] = MFMA16(a, bb, o[q]); } }
#pragma unroll
            for (int j = 0; j < 4; ++j) { float p = (o[0][j] * o[0][j] + o[1][j] * o[1][j]) + (o[2][j] * o[2][j] + o[3][j] * o[3][j]);
                p += __shfl_xor(p, 1); p += __shfl_xor(p, 2); p += __shfl_xor(p, 4); p += __shfl_xor(p, 8);
                if (lr == 0) ssqp[vh * 64 + 16 * tt + 4 * lq + j] = p; }
            __syncthreads();
#pragma unroll
            for (int j = 0; j < 4; ++j) { const int t = 16 * tt + 4 * lq + j; const float rinv = rsqrtf((ssqp[t] + ssqp[64 + t]) * (1.0f / 128.0f) + EPS); const size_t row = rowbase + t;
#pragma unroll
                for (int q = 0; q < 4; ++q) { const int v = 16 * (4 * vh + q) + lr; const float hgv = bf2f(P[row * DIN + 2560 + h * 128 + v]);
                    Y[row * DM + DRG + h * 128 + v] = (bf16)f2bf(o[q][j] * rinv * gnorm[v] * (hgv * sigm(hgv))); } }
        }
#pragma unroll
        for (int ks = 0; ks < 2; ++ks) { const bf16x8 a = *(const LAS bf16x8*)(KhT + (16 * wave + lr) * 72 + ks * 32 + lq * 8);
#pragma unroll
            for (int tv = 0; tv < 8; ++tv) { const bf16x8 bb = *(const LAS bf16x8*)(VT + (16 * tv + lr) * 72 + ks * 32 + lq * 8); S[tv] = MFMA16(a, bb, S[tv]); } }
#pragma unroll
        for (int j = 0; j < 4; ++j) { const float e = eb[16 * wave + 4 * lq + j];
#pragma unroll
            for (int tv = 0; tv < 8; ++tv) S[tv][j] *= e; }
        if (FINAL) {
#pragma unroll
            for (int tv = 0; tv < 8; ++tv) { v2u w; w.x = pk2(S[tv][0], S[tv][1]); w.y = pk2(S[tv][2], S[tv][3]); *(LAS v2u*)(St + (16 * tv + lr) * 136 + 16 * wave + 4 * lq) = w; }
        }
    }
    if (!FINAL) {
        float* dst = is_meta ? (Smeta + (size_t)h * 128 * 128) : (Sloc + (size_t)item * 128 * 128);
#pragma unroll
        for (int j = 0; j < 4; ++j) { const int kr = 16 * wave + 4 * lq + j;
#pragma unroll
            for (int tv = 0; tv < 8; ++tv) dst[(size_t)kr * 128 + 16 * tv + lr] = S[tv][j]; }
        if (!is_meta && g == 0) Btot[(size_t)item * 128 + k] = btot;
    }
}

struct Args { const float* in[19]; float* out; unsigned char* ws; int ph_lo, ph_hi; };
__global__ void __launch_bounds__(512, 2) fwd_megakernel(Args args) {
    extern __shared__ __attribute__((aligned(16))) unsigned char lds_raw[];
    LAS unsigned char* lds = (LAS unsigned char*)lds_raw;
    cg::grid_group grid = cg::this_grid();
    const int tid = threadIdx.x, lane = tid & 63, wave = __builtin_amdgcn_readfirstlane(tid >> 6);
    const int G = gridDim.x, bx = blockIdx.x;
    unsigned char* ws = args.ws;
    const float* x = args.in[0]; const float* meta = args.in[1]; const float* mix_g = args.in[2]; const float* w_in = args.in[3];
    const float* conv_w = args.in[4]; const float* conv_b = args.in[5]; const float* w_rg = args.in[6]; const float* b_rg = args.in[7];
    const float* w_ig = args.in[8]; const float* b_ig = args.in[9]; const float* lam = args.in[10]; const float* rg_g = args.in[11];
    const float* hg_lb = args.in[12]; const float* hg_g = args.in[13]; const float* w_out = args.in[14]; const float* ffn_g = args.in[15];
    const float* w_gu = args.in[16]; const float* w_down = args.in[17]; const float* fin_g = args.in[18];
    bf16* Win_t = (bf16*)(ws + WS_WIN); bf16* Wo_t = (bf16*)(ws + WS_WO); bf16* Wgu_t = (bf16*)(ws + WS_WGU); bf16* Wd_t = (bf16*)(ws + WS_WD); bf16* Wg_t = (bf16*)(ws + WS_WG);
    float* Aseg = (float*)(ws + WS_RGA); float* Hseg = (float*)(ws + WS_RGH); float* hmeta = (float*)(ws + WS_HM); float* Btot = (float*)(ws + WS_BT); float* Smeta = (float*)(ws + WS_SM);
    float* SSQ1 = (float*)(ws + WS_SSQ1); float* SSQ2 = (float*)(ws + WS_SSQ2); float* Sloc = (float*)(ws + WS_SL);
    bf16* XN = (bf16*)(ws + WS_XN); bf16* H1B = (bf16*)(ws + WS_XN); bf16* Y = (bf16*)(ws + WS_Y); bf16* P = (bf16*)(ws + WS_P); bf16* ACT = (bf16*)(ws + WS_P);
    float* out = args.out;
    const int lo = args.ph_lo, hi = args.ph_hi;
#define IN(k) (lo <= (k) && (k) < hi)
#define SEAM(k) do { if (IN(k) && IN((k) + 1)) grid.sync(); } while (0)

    if (IN(0) && !(SKIPMASK & 1)) {
        const int gw = bx * 8 + wave, NGW = G * 8;
        if (bx < 24) {
            LAS float* um = (LAS float*)lds;
            LAS float* red = (LAS float*)(lds + 65536);
#pragma unroll
            for (int r = 0; r < 2; ++r) { const int m = wave * 2 + r; const f32x4* xr = (const f32x4*)(meta + (size_t)m * DM) + lane; const f32x4* gr = (const f32x4*)mix_g + lane;
                f32x4 v[4]; float s = 0.f;
#pragma unroll
                for (int j = 0; j < 4; ++j) { v[j] = xr[64 * j]; s += (v[j].x * v[j].x + v[j].y * v[j].y) + (v[j].z * v[j].z + v[j].w * v[j].w); }
                const float rinv = rsqrtf(wave_sum(s) * (1.f / DM) + EPS);
#pragma unroll
                for (int j = 0; j < 4; ++j) { const f32x4 gg = gr[64 * j]; const int k0 = 256 * j + 4 * lane;
                    um[(k0 + 0) * 16 + m] = v[j].x * rinv * gg.x; um[(k0 + 1) * 16 + m] = v[j].y * rinv * gg.y; um[(k0 + 2) * 16 + m] = v[j].z * rinv * gg.z; um[(k0 + 3) * 16 + m] = v[j].w * rinv * gg.w; } }
            __syncthreads();
            const int kg = tid >> 7, nl = tid & 127, n = bx * 128 + nl;
            float acc[16];
#pragma unroll
            for (int m = 0; m < 16; ++m) acc[m] = 0.f;
            for (int kk = kg * 256; kk < kg * 256 + 256; ++kk) { const float w = w_in[(size_t)kk * DIN + n]; const LAS f32x4* u4 = (const LAS f32x4*)(um + kk * 16);
#pragma unroll
                for (int q = 0; q < 4; ++q) { const f32x4 uv = u4[q]; acc[4 * q + 0] += w * uv.x; acc[4 * q + 1] += w * uv.y; acc[4 * q + 2] += w * uv.z; acc[4 * q + 3] += w * uv.w; } }
#pragma unroll
            for (int m = 0; m < 16; ++m) red[(kg * 16 + m) * 128 + nl] = acc[m];
            __syncthreads();
            for (int o = tid; o < 2048; o += 512) { const int m = o >> 7, n2 = o & 127;
                const float s = (red[(0 * 16 + m) * 128 + n2] + red[(1 * 16 + m) * 128 + n2]) + (red[(2 * 16 + m) * 128 + n2] + red[(3 * 16 + m) * 128 + n2]);
                P[(size_t)(MROWS + m) * DIN + bx * 128 + n2] = (bf16)f2bf(s); }
            __syncthreads();
        }
        LAS float* scr = (LAS float*)(lds + wave * 16384);
        constexpr int I_IN = (DM / 64) * (DIN / 32), I_O = (DM / 64) * (DM / 32), I_GU = (DM / 64) * (2 * DFF / 32), I_D = (DFF / 64) * (DM / 32);
        constexpr int NITEMS = I_IN + I_O + I_GU + I_D;
        for (int it = gw; it < NITEMS; it += NGW) {
            int r = it;
            if (r < I_IN) { p0_transpose_item(w_in, DM, DIN, Win_t, scr, r, lane, 0, nullptr); continue; } r -= I_IN;
            if (r < I_O) { p0_transpose_item(w_out, DM, DM, Wo_t, scr, r, lane, 0, nullptr); continue; } r -= I_O;
            if (r < I_GU) { p0_transpose_item(w_gu, DM, 2 * DFF, Wgu_t, scr, r, lane, 1, ffn_g); continue; } r -= I_GU;
            p0_transpose_item(w_down, DFF, DM, Wd_t, scr, r, lane, 0, nullptr);
        }
        for (int i = bx * 512 + tid; i < 2 * 8 * 64 * 64; i += G * 512) {
            const int gt = i >> 15, hh = (i >> 12) & 7, j = (i >> 6) & 63, ii = i & 63;
            Wg_t[i] = (bf16)f2bf((gt ? w_ig : w_rg)[hh * 4096 + ii * 64 + j]); }
        for (int m = gw; m < MROWS; m += NGW) rms_row_to_bf16(x + (size_t)m * DM, mix_g, XN + (size_t)m * DM, lane);
    }
    SEAM(0);
    if (IN(1) && !(SKIPMASK & 2)) {
        pg8::Gemm g{XN, Win_t, MROWS, DIN, DM}; pg8::StaticOrder S; S.init(MROWS, DIN, G, bx);
        pg8::EpiP E{P, DIN};
        pg8::gemm_phase<pg8::EpiP, pg8::StaticOrder, true, true>(lds, g, S, E);
    }
    SEAM(1);
    if (IN(2) && !(SKIPMASK & 4)) {
        for (int it = bx; it < 256; it += G) {
            int wv = wave, ln = lane, td = tid; asm volatile("" : "+s"(wv), "+v"(ln), "+v"(td));
#ifndef NO_RG
            rg_run<false>(lds, P, Wg_t, conv_w, conv_b, b_rg, b_ig, lam, rg_g, Aseg, Hseg, hmeta, Y, it >> 5, it & 31, false, wv, ln);
            if (it == 255) rg_run<false>(lds, P, Wg_t, conv_w, conv_b, b_rg, b_ig, lam, rg_g, Aseg, Hseg, hmeta, Y, 0, 0, true, wv, ln);
#endif
            __syncthreads();
#ifndef NO_HG
            hg_run<false>(lds, P, hg_lb, hg_g, Sloc, Btot, Smeta, Y, it >> 5, (it >> 3) & 3, it & 7, false, td, wv, ln);
            __syncthreads();
            if (it < 4) { hg_run<false>(lds, P, hg_lb, hg_g, Sloc, Btot, Smeta, Y, 0, it, 0, true, td, wv, ln); __syncthreads(); }
#endif
        }
    }
    SEAM(2);
    if (IN(3) && !(SKIPMASK & 8)) {
        for (int it = bx; it < 256; it += G) {
            int wv = wave, ln = lane, td = tid; asm volatile("" : "+s"(wv), "+v"(ln), "+v"(td));
#ifndef NO_RG
            rg_run<true>(lds, P, Wg_t, conv_w, conv_b, b_rg, b_ig, lam, rg_g, Aseg, Hseg, hmeta, Y, it >> 5, it & 31, false, wv, ln);
            __syncthreads();
#endif
#ifndef NO_HG
            hg_run<true>(lds, P, hg_lb, hg_g, Sloc, Btot, Smeta, Y, it >> 5, (it >> 3) & 3, it & 7, false, td, wv, ln);
            __syncthreads();
#endif
        }
    }
    SEAM(3);
    if (IN(4) && !(SKIPMASK & 16)) {
        pg8::Gemm g{Y, Wo_t, MROWS, DM, DM}; pg8::StaticOrder S; S.init(MROWS, DM, G, bx);
        pg8::EpiOut E{x, out, H1B, SSQ1};
        pg8::gemm_phase<pg8::EpiOut, pg8::StaticOrder, true, true>(lds, g, S, E);
    }
    SEAM(4);
    if (IN(5) && !(SKIPMASK & 32)) {
        pg8::Gemm g{H1B, Wgu_t, MROWS, 2 * DFF, DM}; pg8::StaticOrder S; S.init(MROWS, 2 * DFF, G, bx);
        pg8::EpiGU E{SSQ1, ACT};
        pg8::gemm_phase<pg8::EpiGU, pg8::StaticOrder, true, true>(lds, g, S, E);
    }
    SEAM(5);
    if (IN(6) && !(SKIPMASK & 64)) {
        pg8::Gemm g{ACT, Wd_t, MROWS, DM, DFF}; pg8::StaticOrder S; S.init(MROWS, DM, G, bx);
        pg8::EpiDown E{out, SSQ2};
        pg8::gemm_phase<pg8::EpiDown, pg8::StaticOrder, true, true>(lds, g, S, E);
    }
    SEAM(6);
    if (IN(7) && !(SKIPMASK & 128)) {
        const int gw = bx * 8 + wave, NGW = G * 8;
        for (int m = gw; m < MROWS; m += NGW) {
            const float sv = (lane < 16) ? SSQ2[(size_t)m * 16 + lane] : 0.f;
            const float rinv = rsqrtf(wave_sum(sv) * (1.f / DM) + EPS);
            f32x4* xr = (f32x4*)(out + (size_t)m * DM) + lane; const f32x4* gr = (const f32x4*)fin_g + lane;
#pragma unroll
            for (int j = 0; j < 4; ++j) { const f32x4 v = xr[64 * j], gg = gr[64 * j]; xr[64 * j] = (f32x4){v.x * rinv * gg.x, v.y * rinv * gg.y, v.z * rinv * gg.z, v.w * rinv * gg.w}; }
        }
    }
#undef IN
#undef SEAM
}

extern "C" void kernel_launch(void* const* d_in, const int* in_sizes, int n_in, void* d_out, int out_size, void* d_ws, size_t ws_size, hipStream_t stream) {
    static int grid = 0;
    if (grid == 0) {
        if (n_in != 19 || in_sizes[0] != MROWS * DM || out_size != MROWS * DM || ws_size < WS_END) { fprintf(stderr, "kernel_launch: unexpected shapes (n_in %d, in0 %d, out %d, ws %zu)\n", n_in, n_in > 0 ? in_sizes[0] : -1, out_size, ws_size); grid = -1; return; }
        int dev = 0, cus = 0, per_cu = 0;
        hipGetDevice(&dev); hipDeviceGetAttribute(&cus, hipDeviceAttributeMultiprocessorCount, dev);
        if (hipFuncSetAttribute((const void*)fwd_megakernel, hipFuncAttributeMaxDynamicSharedMemorySize, LDS_BYTES) != hipSuccess) { fprintf(stderr, "kernel_launch: hipFuncSetAttribute failed\n"); grid = -1; return; }
        if (hipOccupancyMaxActiveBlocksPerMultiprocessor(&per_cu, (const void*)fwd_megakernel, 512, LDS_BYTES) != hipSuccess || per_cu < 1) { fprintf(stderr, "kernel_launch: occupancy query gave %d\n", per_cu); per_cu = 1; }
        (void)hipGetLastError();
        grid = cus * per_cu;
        fprintf(stderr, "kernel_launch: grid %d (cus %d x %d)\n", grid, cus, per_cu);
    }
    if (grid < 0) return;
    Args a{};
    for (int i = 0; i < 19; ++i) a.in[i] = (const float*)d_in[i];
    a.out = (float*)d_out; a.ws = (unsigned char*)d_ws;
#if MK_N_LAUNCHES == 1
    a.ph_lo = 0; a.ph_hi = NPH;
    void* kargs[] = {&a};
    hipError_t e = hipLaunchCooperativeKernel((const void*)fwd_megakernel, dim3(grid), dim3(512), kargs, LDS_BYTES, stream);
    if (e != hipSuccess) fprintf(stderr, "kernel_launch: cooperative launch failed: %s (grid %d)\n", hipGetErrorString(e), grid);
#else
    for (int p = 0; p < NPH; ++p) { a.ph_lo = p; a.ph_hi = p + 1; hipLaunchKernelGGL(fwd_megakernel, dim3(grid), dim3(512), LDS_BYTES, stream, a); }
#endif
}
```

```cpp
#include <hip/hip_runtime.h>
#include <hip/hip_cooperative_groups.h>
#include <cstdio>
#include <cstdint>
namespace cg = cooperative_groups;
namespace pg8 {
#define PG8_LAS __attribute__((address_space(3)))
typedef unsigned short bf16_t;
typedef short bf16x8 __attribute__((ext_vector_type(8)));
typedef float f32x4 __attribute__((ext_vector_type(4)));
typedef unsigned u32x4 __attribute__((ext_vector_type(4)));
constexpr int BM = 256, BK = 64, HALF = 128, HTB = HALF * BK * 2  , STAGE_BYTES = 8 * HTB, NXCD = 8, WGM = 8;

__host__ __device__ __forceinline__ int lds_byte(int r, int c) { const int st = (r >> 4) * 2 + (c >> 5), rr = r & 15, cc = c & 31, ob = rr * 64 + cc * 2; return st * 1024 + (ob ^ (((ob >> 9) & 1) << 5)); }
__host__ __device__ __forceinline__ void stage_rc(int b, int& R, int& C) { const int st = b / 1024, sb = b % 1024, swz = sb ^ (((sb >> 9) & 1) << 5); R = (st >> 1) * 16 + swz / 64; C = (st & 1) * 32 + (swz % 64) / 2; }
__host__ __device__ __forceinline__ int perm32(int rho) { const int n = rho >> 4, i = rho & 15; return 8 * (i >> 2) + 4 * n + (i & 3); }

struct Unit { int pm, pn; };
struct Gemm { const bf16_t* A; const bf16_t* Bt; int M, N, K; };

struct StaticOrder {
    int nM, nN, nwg, G, c;
    __host__ __device__ void init(int M, int N, int G_, int c_) { nM = M / BM; nN = N / BM; nwg = nM * nN; G = G_; c = c_; }
    __host__ __device__ bool next(int i, Unit& u) const {
        const long L = (long)i * G + c; if (L >= nwg) return false;
        int wgid = (int)L; { const int q = nwg / NXCD, r = nwg % NXCD, xcd = wgid % NXCD, off = wgid / NXCD; wgid = (xcd < r ? xcd * (q + 1) : r * (q + 1) + (xcd - r) * q) + off; }
        const int nig = WGM * nN, gid = wgid / nig, fm = gid * WGM, gsz = (nM - fm) < WGM ? (nM - fm) : WGM;
        u.pm = fm + ((wgid % nig) % gsz); u.pn = (wgid % nig) / gsz; return true;
    }
    __device__ __forceinline__ void a_ready(const Unit&) const {}
    __device__ __forceinline__ void done(const Unit&) const {}
};

__device__ __forceinline__ unsigned cvt_pk_bf16(float lo, float hi) { unsigned r; asm volatile("v_cvt_pk_bf16_f32 %0, %1, %2" : "=v"(r) : "v"(lo), "v"(hi)); return r; }
typedef unsigned u32x2 __attribute__((ext_vector_type(2)));
struct EpiP {
    static constexpr bool PERM = true, AFTER_DRAIN = false;
    bf16_t* O; int ldc;
    __device__ __forceinline__ void operator()(const f32x4 (&acc)[2][2][4][2], const Unit& u, int wr, int wc, int fr, int fq) const {
        const int row0 = u.pm * BM + wr * 64 + fr, col0 = u.pn * BM + wc * 32 + 8 * fq;
#pragma unroll
        for (int ai = 0; ai < 2; ++ai)
#pragma unroll
            for (int m = 0; m < 4; ++m) { bf16_t* rowp = O + (size_t)(row0 + ai * HALF + m * 16) * ldc + col0;
#pragma unroll
                for (int bj = 0; bj < 2; ++bj) { const f32x4 v0 = acc[ai][bj][m][0], v1 = acc[ai][bj][m][1];
                    u32x4 w; w.x = cvt_pk_bf16(v0[0], v0[1]); w.y = cvt_pk_bf16(v0[2], v0[3]); w.z = cvt_pk_bf16(v1[0], v1[1]); w.w = cvt_pk_bf16(v1[2], v1[3]);
                    *(u32x4*)(rowp + bj * HALF) = w; } }
    }
};
struct EpiOut {
    static constexpr bool PERM = false, AFTER_DRAIN = false;
    const float* x; bf16_t* hb; float* ssq;
    __device__ __forceinline__ void operator()(const f32x4 (&acc)[2][2][4][2], const Unit& u, int wr, int wc, int fr, int fq) const {
        const int row0 = u.pm * BM + wr * 64 + fr, col0 = u.pn * BM + wc * 32 + 4 * fq;
#pragma unroll
        for (int ai = 0; ai < 2; ++ai)
#pragma unroll
            for (int m = 0; m < 4; ++m) { const int row = row0 + ai * HALF + m * 16; const size_t off = (size_t)row * 1024 + col0; float s = 0.f;
#pragma unroll
                for (int bj = 0; bj < 2; ++bj)
#pragma unroll
                    for (int n = 0; n < 2; ++n) { const size_t o = off + bj * HALF + n * 16; const f32x4 xv = *(const f32x4*)(x + o); const f32x4 hv = xv + acc[ai][bj][m][n];
                        s += (hv[0] * hv[0] + hv[1] * hv[1]) + (hv[2] * hv[2] + hv[3] * hv[3]);
                        u32x2 w; w.x = cvt_pk_bf16(hv[0], hv[1]); w.y = cvt_pk_bf16(hv[2], hv[3]); *(u32x2*)(hb + o) = w; }
                s += __shfl_xor(s, 16); s += __shfl_xor(s, 32);
                if (fq == 0) ssq[(size_t)row * 16 + u.pn * 4 + wc] = s; }
    }
};
struct EpiGU {
    static constexpr bool PERM = true, AFTER_DRAIN = false;
    const float* ssq; bf16_t* act;
    __device__ __forceinline__ void operator()(const f32x4 (&acc)[2][2][4][2], const Unit& u, int wr, int wc, int fr, int fq) const {
        const int row0 = u.pm * BM + wr * 64 + fr, col0 = u.pn * 128 + wc * 32 + 8 * fq;
#pragma unroll
        for (int ai = 0; ai < 2; ++ai)
#pragma unroll
            for (int m = 0; m < 4; ++m) { const int row = row0 + ai * HALF + m * 16; const f32x4* sp = (const f32x4*)(ssq + (size_t)row * 16);
                const f32x4 s0 = sp[0], s1 = sp[1], s2 = sp[2], s3 = sp[3]; const f32x4 st = (s0 + s1) + (s2 + s3);
                const float rinv = rsqrtf(((st[0] + st[1]) + (st[2] + st[3])) * (1.0f / 1024.0f) + 1e-6f);
                float a[8];
#pragma unroll
                for (int n = 0; n < 2; ++n)
#pragma unroll
                    for (int j = 0; j < 4; ++j) { const float g = acc[ai][0][m][n][j] * rinv, up = acc[ai][1][m][n][j] * rinv; a[4 * n + j] = g * __builtin_amdgcn_rcpf(1.0f + __expf(-g)) * up; }
                u32x4 w; w.x = cvt_pk_bf16(a[0], a[1]); w.y = cvt_pk_bf16(a[2], a[3]); w.z = cvt_pk_bf16(a[4], a[5]); w.w = cvt_pk_bf16(a[6], a[7]);
                *(u32x4*)(act + (size_t)row * 2816 + col0) = w; }
    }
};
struct EpiDown {
    static constexpr bool PERM = false, AFTER_DRAIN = false;
    bf16_t* hb; float* ssq;
    __device__ __forceinline__ void operator()(const f32x4 (&acc)[2][2][4][2], const Unit& u, int wr, int wc, int fr, int fq) const {
        const int row0 = u.pm * BM + wr * 64 + fr, col0 = u.pn * BM + wc * 32 + 4 * fq;
#pragma unroll
        for (int ai = 0; ai < 2; ++ai)
#pragma unroll
            for (int m = 0; m < 4; ++m) { const int row = row0 + ai * HALF + m * 16; const size_t off = (size_t)row * 1024 + col0; float s = 0.f;
#pragma unroll
                for (int bj = 0; bj < 2; ++bj)
#pragma unroll
                    for (int n = 0; n < 2; ++n) { const size_t o = off + bj * HALF + n * 16; const u32x2 xb = *(const u32x2*)(hb + o); const f32x4 xv = {__uint_as_float(xb.x << 16), __uint_as_float(xb.x & 0xffff0000u), __uint_as_float(xb.y << 16), __uint_as_float(xb.y & 0xffff0000u)}; const f32x4 hv = xv + acc[ai][bj][m][n];
                        s += (hv[0] * hv[0] + hv[1] * hv[1]) + (hv[2] * hv[2] + hv[3] * hv[3]);
                        u32x2 w; w.x = cvt_pk_bf16(hv[0], hv[1]); w.y = cvt_pk_bf16(hv[2], hv[3]); *(u32x2*)(hb + o) = w; }
                s += __shfl_xor(s, 16); s += __shfl_xor(s, 32);
                if (fq == 0) ssq[(size_t)row * 16 + u.pn * 4 + wc] = s; }
    }
};
template <class Epi, class Sched, bool ALIGN_EPI = false, bool SP2 = false>
__device__ __forceinline__ void gemm_phase(PG8_LAS unsigned char* lds, const Gemm g, const Sched& S, const Epi& E) {
    const int tid = threadIdx.x, wid = __builtin_amdgcn_readfirstlane(tid >> 6), lane = tid & 63, wr = wid >> 2, wc = wid & 3, fr = lane & 15, fq = lane >> 4;
    const int K = g.K, nt = K / BK;
    unsigned voffA[2], voffB[2];
#pragma unroll
    for (int i = 0; i < 2; ++i) { int R, C; stage_rc(tid * 16 + i * 8192, R, C); const int Rb = Epi::PERM ? ((R & ~31) + perm32(R & 31)) : R;
        voffA[i] = (unsigned)(R * K + C) * 2u; voffB[i] = (unsigned)(Rb * K + C) * 2u; }
    const size_t kstep = (size_t)(BK * 2);
    const size_t hstep = (size_t)HALF * K * 2;
    const size_t tstep = 2 * hstep;
    const unsigned ldsw = (unsigned)wid * 1024u;
    const int aoff = lds_byte(wr * 64 + fr, fq * 8), boff = lds_byte(wc * 32 + fr, fq * 8);
#define PG8_SA(b, h) (((b) * 2 + (h)) * HTB)
#define PG8_SB(b, h) ((4 + (b) * 2 + (h)) * HTB)
#define PG8_STAGE(bufoff, gbase, voff) do { _Pragma("unroll") for (int _i = 0; _i < 2; ++_i) \
        __builtin_amdgcn_global_load_lds((const unsigned*)((const char*)(gbase) + (voff)[_i]), (PG8_LAS unsigned*)(lds + (bufoff) + ldsw + _i * 8192), 16, 0, 0); } while (0)
#define PG8_LDA(dst, b, h) do { _Pragma("unroll") for (int m = 0; m < 4; ++m) _Pragma("unroll") for (int k = 0; k < 2; ++k) dst[m][k] = *(const PG8_LAS bf16x8*)(lds + PG8_SA(b, h) + aoff + m * 2048 + k * 1024); } while (0)
#define PG8_LDB(dst, b, h) do { _Pragma("unroll") for (int n = 0; n < 2; ++n) _Pragma("unroll") for (int k = 0; k < 2; ++k) dst[n][k] = *(const PG8_LAS bf16x8*)(lds + PG8_SB(b, h) + boff + n * 2048 + k * 1024); } while (0)
#define PG8_MMA(ai, bj, At, Bt) do { __builtin_amdgcn_s_setprio(1); _Pragma("unroll") for (int m = 0; m < 4; ++m) _Pragma("unroll") for (int n = 0; n < 2; ++n) _Pragma("unroll") for (int k = 0; k < 2; ++k) \
        acc[ai][bj][m][n] = __builtin_amdgcn_mfma_f32_16x16x32_bf16(Bt[n][k], At[m][k], acc[ai][bj][m][n], 0, 0, 0); __builtin_amdgcn_s_setprio(0); } while (0)
#define PG8_WAIT_V(n) asm volatile("s_waitcnt vmcnt(" #n ")" ::: "memory")
#define PG8_WAIT_L(n) asm volatile("s_waitcnt lgkmcnt(" #n ")" ::: "memory")
#define PG8_BAR __builtin_amdgcn_s_barrier()
#define PG8_SCHED __builtin_amdgcn_sched_barrier(0)
    Unit cur, nxt; int ui = 0;
    if (!S.next(0, cur)) return;
    f32x4 acc[2][2][4][2];
#pragma unroll
    for (int a = 0; a < 2; ++a)
#pragma unroll
        for (int b = 0; b < 2; ++b)
#pragma unroll
            for (int m = 0; m < 4; ++m)
#pragma unroll
                for (int n = 0; n < 2; ++n) acc[a][b][m][n] = (f32x4){0.f, 0.f, 0.f, 0.f};
    bf16x8 At[4][2], B0[2][2], B1[2][2];
    const char* cA = (const char*)g.A + (size_t)cur.pm * tstep; const char* cB = (const char*)g.Bt + (size_t)cur.pn * tstep;
    S.a_ready(cur);
    if constexpr (SP2) {
        PG8_STAGE(PG8_SB(0, 0), cB, voffB); PG8_STAGE(PG8_SB(0, 1), cB + hstep, voffB); PG8_STAGE(PG8_SA(0, 0), cA, voffA); PG8_STAGE(PG8_SA(0, 1), cA + hstep, voffA);
        if (wr == 1) PG8_BAR;
        PG8_WAIT_V(2); PG8_BAR;
        PG8_STAGE(PG8_SB(1, 0), cB + kstep, voffB); PG8_STAGE(PG8_SA(1, 0), cA + kstep, voffA); PG8_STAGE(PG8_SB(1, 1), cB + hstep + kstep, voffB);
        PG8_WAIT_V(6); PG8_BAR;
    } else {
        PG8_STAGE(PG8_SB(0, 0), cB, voffB); PG8_STAGE(PG8_SA(0, 0), cA, voffA); PG8_STAGE(PG8_SB(0, 1), cB + hstep, voffB); PG8_STAGE(PG8_SA(0, 1), cA + hstep, voffA);
        if (wr == 1) PG8_BAR;
        PG8_WAIT_V(4); PG8_BAR;
        PG8_STAGE(PG8_SB(1, 0), cB + kstep, voffB); PG8_STAGE(PG8_SA(1, 0), cA + kstep, voffA); PG8_STAGE(PG8_SB(1, 1), cB + hstep + kstep, voffB);
        PG8_WAIT_V(6); PG8_BAR;
    }
    for (;;) {
        const bool has_next = S.next(ui + 1, nxt);
        const char* nA = has_next ? (const char*)g.A + (size_t)nxt.pm * tstep : cA; const char* nB = has_next ? (const char*)g.Bt + (size_t)nxt.pn * tstep : cB;
        for (int t = 0; t < nt; t += 2) {
            const bool last = (t == nt - 2);
            const char* a1 = cA + (size_t)(t + 1) * kstep;
            const char* a2 = last ? nA : cA + (size_t)(t + 2) * kstep; const char* b2 = last ? nB : cB + (size_t)(t + 2) * kstep;
            const char* a3 = a2 + kstep; const char* b3 = b2 + kstep;
            if (last && has_next) S.a_ready(nxt);
            if constexpr (SP2) {
            PG8_LDB(B0, 0, 0); PG8_LDB(B1, 0, 1); PG8_SCHED; PG8_LDA(At, 0, 0); PG8_STAGE(PG8_SA(1, 1), a1 + hstep, voffA);
            PG8_WAIT_V(8); PG8_WAIT_L(0); PG8_BAR; PG8_MMA(0, 0, At, B0); PG8_MMA(0, 1, At, B1); PG8_BAR; PG8_SCHED;
            PG8_LDA(At, 0, 1); PG8_STAGE(PG8_SB(0, 0), b2, voffB); PG8_STAGE(PG8_SB(0, 1), b2 + hstep, voffB); PG8_STAGE(PG8_SA(0, 0), a2, voffA);
            PG8_WAIT_V(8); PG8_WAIT_L(0); PG8_BAR; PG8_MMA(1, 0, At, B0); PG8_MMA(1, 1, At, B1); PG8_BAR; PG8_SCHED;
            PG8_LDB(B0, 1, 0); PG8_LDB(B1, 1, 1); PG8_SCHED; PG8_LDA(At, 1, 0); PG8_STAGE(PG8_SA(0, 1), a2 + hstep, voffA);
            PG8_WAIT_V(8); PG8_WAIT_L(0); PG8_BAR; PG8_MMA(0, 0, At, B0); PG8_MMA(0, 1, At, B1); PG8_BAR; PG8_SCHED;
            PG8_LDA(At, 1, 1); PG8_STAGE(PG8_SB(1, 0), b3, voffB); PG8_STAGE(PG8_SB(1, 1), b3 + hstep, voffB); PG8_STAGE(PG8_SA(1, 0), a3, voffA);
            PG8_WAIT_V(8); PG8_WAIT_L(0); PG8_BAR; PG8_MMA(1, 0, At, B0); PG8_MMA(1, 1, At, B1); PG8_BAR; PG8_SCHED;
            } else {
            PG8_LDB(B0, 0, 0); PG8_SCHED; PG8_LDA(At, 0, 0); PG8_STAGE(PG8_SA(1, 1), a1 + hstep, voffA);
            PG8_WAIT_L(8); PG8_BAR; PG8_WAIT_L(0); PG8_MMA(0, 0, At, B0); PG8_BAR; PG8_SCHED;
            PG8_LDB(B1, 0, 1); PG8_STAGE(PG8_SB(0, 0), b2, voffB);
            PG8_BAR; PG8_WAIT_L(0); PG8_MMA(0, 1, At, B1); PG8_BAR;
            PG8_LDA(At, 0, 1); PG8_STAGE(PG8_SA(0, 0), a2, voffA);
            PG8_BAR; PG8_WAIT_L(0); PG8_MMA(1, 0, At, B0); PG8_BAR; PG8_SCHED;
            PG8_STAGE(PG8_SB(0, 1), b2 + hstep, voffB);
            PG8_WAIT_V(6); PG8_BAR; PG8_MMA(1, 1, At, B1); PG8_BAR;
            PG8_LDB(B0, 1, 0); PG8_SCHED; PG8_LDA(At, 1, 0); PG8_STAGE(PG8_SA(0, 1), a2 + hstep, voffA);
            PG8_WAIT_L(8); PG8_BAR; PG8_WAIT_L(0); PG8_MMA(0, 0, At, B0); PG8_BAR; PG8_SCHED;
            PG8_LDB(B1, 1, 1); PG8_STAGE(PG8_SB(1, 0), b3, voffB);
            PG8_BAR; PG8_WAIT_L(0); PG8_MMA(0, 1, At, B1); PG8_BAR;
            PG8_LDA(At, 1, 1); PG8_STAGE(PG8_SA(1, 0), a3, voffA);
            PG8_BAR; PG8_WAIT_L(0); PG8_MMA(1, 0, At, B0); PG8_BAR; PG8_SCHED;
            PG8_STAGE(PG8_SB(1, 1), b3 + hstep, voffB);
            PG8_WAIT_V(6); PG8_BAR; PG8_MMA(1, 1, At, B1); PG8_BAR;
            }
        }
        if constexpr (ALIGN_EPI) { if (wr == 0) PG8_BAR; }
        if constexpr (!Epi::AFTER_DRAIN) { E(acc, cur, wr, wc, fr, fq); S.done(cur); }
        if (!has_next) break;
#pragma unroll
        for (int a = 0; a < 2; ++a)
#pragma unroll
            for (int b = 0; b < 2; ++b)
#pragma unroll
                for (int m = 0; m < 4; ++m)
#pragma unroll
                    for (int n = 0; n < 2; ++n) acc[a][b][m][n] = (f32x4){0.f, 0.f, 0.f, 0.f};
        cur = nxt; cA = nA; cB = nB; ++ui;
        if constexpr (ALIGN_EPI) { if (wr == 1) PG8_BAR; }
    }
    PG8_WAIT_V(0);
    if constexpr (!ALIGN_EPI) { if (wr == 0) PG8_BAR; }
    PG8_BAR;
    if constexpr (Epi::AFTER_DRAIN) { E.fused(acc, cur, wr, wc, fr, fq, lds, wid, lane); S.done(cur); }
#undef PG8_SA
#undef PG8_SB
#undef PG8_STAGE
#undef PG8_LDA
#undef PG8_LDB
#undef PG8_MMA
#undef PG8_WAIT_V
#undef PG8_WAIT_L
#undef PG8_BAR
#undef PG8_SCHED
}
}

#ifndef MK_N_LAUNCHES
#define MK_N_LAUNCHES 1
#endif
#ifndef REPMASK
#define REPMASK 0
#endif
#define REP(k) _Pragma("unroll") for (int rep_ = 0; rep_ < (((REPMASK) >> (k)) & 1) + 1; ++rep_)
#ifndef SKIPMASK
#define SKIPMASK 0
#endif
constexpr int NPH = 8;
constexpr int NB = 8, SEQ = 4096, DM = 1024, NMETA = 16, DIN = 3072, DRG = 512, DFF = 2816;
constexpr int MROWS = NB * SEQ;
constexpr float EPS = 1e-6f;
constexpr size_t MiB = 1u << 20;
constexpr size_t WS_WIN = 0, WS_WO = 6 * MiB, WS_WGU = 8 * MiB, WS_WD = 19 * MiB, WS_WG = 25 * MiB;
constexpr size_t WS_RGA = 26 * MiB, WS_RGH = 26 * MiB + 512 * 1024, WS_HM = 27 * MiB, WS_BT = 27 * MiB + 64 * 1024, WS_SM = 28 * MiB;
constexpr size_t WS_SSQ1 = 30 * MiB, WS_SSQ2 = 32 * MiB, WS_SL = 34 * MiB;
constexpr size_t WS_XN = 64 * MiB;
constexpr size_t WS_Y = 128 * MiB;
constexpr size_t WS_P = 192 * MiB;
constexpr size_t WS_END = 392 * MiB;
constexpr int LDS_BYTES = 147456;

#define LAS __attribute__((address_space(3)))
typedef unsigned short bf16;
typedef float f32x4 __attribute__((ext_vector_type(4)));
typedef short bf16x8 __attribute__((ext_vector_type(8)));
typedef unsigned v4u __attribute__((ext_vector_type(4)));
typedef unsigned v2u __attribute__((ext_vector_type(2)));
__device__ __forceinline__ float bf2f(unsigned short b) { return __uint_as_float(((unsigned)b) << 16); }
__device__ __forceinline__ unsigned f2bf(float f) { unsigned u = __float_as_uint(f); return (u + 0x7fffu + ((u >> 16) & 1u)) >> 16; }
__device__ __forceinline__ unsigned pk2(float lo, float hi) { return f2bf(lo) | (f2bf(hi) << 16); }
__device__ __forceinline__ float sigm(float x) { return __builtin_amdgcn_rcpf(1.0f + __expf(-x)); }
__device__ __forceinline__ float wave_sum(float v) {
#pragma unroll
    for (int o = 1; o < 64; o <<= 1) v += __shfl_xor(v, o);
    return v;
}
#define MFMA16(a, b, c) __builtin_amdgcn_mfma_f32_16x16x32_bf16((a), (b), (c), 0, 0, 0)

__device__ __forceinline__ void p0_transpose_item(const float* W, int K, int N, bf16* WT, LAS float* scr, int item, int lane, int mode, const float* ksc) {
    const int nblk = N / 32, kb = item / nblk, nb = item % nblk, k0 = 64 * kb, n0 = 32 * nb;
    int src0 = n0;
    if (mode == 1) { const int t = n0 >> 8, c = n0 & 255; src0 = (c < 128) ? (t * 128 + c) : (DFF + t * 128 + (c - 128)); }
#pragma unroll 8
    for (int i = 0; i < 32; ++i) { const int kk = 2 * i + (lane >> 5); float v = W[(size_t)(k0 + kk) * N + src0 + (lane & 31)]; if (mode == 1) v *= ksc[k0 + kk]; scr[kk * 33 + (lane & 31)] = v; }
    asm volatile("s_waitcnt lgkmcnt(0)" ::: "memory");
    const int c = lane & 7;
#pragma unroll
    for (int j = 0; j < 4; ++j) { const int n = (lane >> 3) + 8 * j; const LAS float* s = scr + (8 * c) * 33 + n;
        v4u o; o.x = pk2(s[0 * 33], s[1 * 33]); o.y = pk2(s[2 * 33], s[3 * 33]); o.z = pk2(s[4 * 33], s[5 * 33]); o.w = pk2(s[6 * 33], s[7 * 33]);
        *(v4u*)(WT + (size_t)(n0 + n) * K + k0 + 8 * c) = o; }
    asm volatile("s_waitcnt lgkmcnt(0)" ::: "memory");
}
__device__ __forceinline__ void rms_row_to_bf16(const float* xrow, const float* g, bf16* orow, int lane) {
    const f32x4* xr = (const f32x4*)xrow + lane; const f32x4* gr = (const f32x4*)g + lane;
    f32x4 v[4]; float s = 0.f;
#pragma unroll
    for (int j = 0; j < 4; ++j) { v[j] = xr[64 * j]; s += (v[j].x * v[j].x + v[j].y * v[j].y) + (v[j].z * v[j].z + v[j].w * v[j].w); }
    const float rinv = rsqrtf(wave_sum(s) * (1.f / DM) + EPS);
    unsigned long long* o8 = (unsigned long long*)orow + lane;
#pragma unroll
    for (int j = 0; j < 4; ++j) { const f32x4 gg = gr[64 * j];
        o8[64 * j] = (unsigned long long)pk2(v[j].x * rinv * gg.x, v[j].y * rinv * gg.y) | ((unsigned long long)pk2(v[j].z * rinv * gg.z, v[j].w * rinv * gg.w) << 32); }
}

constexpr int RG_WAVE_LDS = 10496;
__device__ __forceinline__ float bflo(unsigned u) { return __uint_as_float(u << 16); }
__device__ __forceinline__ float bfhi(unsigned u) { return __uint_as_float(u & 0xffff0000u); }
__device__ __forceinline__ unsigned cvtpk(float lo, float hi) { unsigned r; asm volatile("v_cvt_pk_bf16_f32 %0, %1, %2" : "=v"(r) : "v"(lo), "v"(hi)); return r; }
__device__ __forceinline__ void rg_scan(LAS unsigned char* lds, const bf16* P, const bf16* Wg, const float* conv_w, const float* conv_b, const float* b_r, const float* b_i, const float* lam,
                                        float* Aseg, float* Hseg, float* hmeta, bf16* HLOC, bf16* PAC, int b, int seg, bool is_meta, int wave, int lane) {
    const int c = wave * 64 + lane;
    LAS bf16* xcb = (LAS bf16*)(lds + wave * RG_WAVE_LDS);
    LAS float* pre_r = (LAS float*)(lds + wave * RG_WAVE_LDS + 2304);
    LAS float* pre_i = pre_r + 1024;
    const float cw0 = conv_w[c], cw1 = conv_w[DRG + c], cw2 = conv_w[2 * DRG + c], cw3 = conv_w[3 * DRG + c], cb = conv_b[c];
    const float br = b_r[c], bi = b_i[c];
    const float sp = 8.0f * log1pf(__expf(-lam[c]));
    bf16x8 bw[2][4][2];
#pragma unroll
    for (int g = 0; g < 2; ++g)
#pragma unroll
        for (int nt = 0; nt < 4; ++nt)
#pragma unroll
            for (int ks = 0; ks < 2; ++ks) bw[g][nt][ks] = *(const bf16x8*)(Wg + ((size_t)(g * 8 + wave) * 64 + nt * 16 + (lane & 15)) * 64 + ks * 32 + (lane >> 4) * 8);
    float h = 0.f, pa = 1.f, xm3 = 0.f, xm2 = 0.f, xm1 = 0.f;
    const int nsb = is_meta ? 1 : 8;
    const size_t row0 = is_meta ? (size_t)MROWS : (size_t)b * SEQ + (size_t)seg * 128;
    if (!is_meta) {
        const size_t r3 = (seg == 0) ? (size_t)MROWS + 13 : row0 - 3;
        xm3 = bf2f(P[r3 * DIN + c]); xm2 = bf2f(P[(r3 + 1) * DIN + c]); xm1 = bf2f(P[(r3 + 2) * DIN + c]);
    }
    for (int sb = 0; sb < nsb; ++sb) {
        const size_t rb = row0 + (size_t)sb * 16;
        float e[19], xc[16];
        e[0] = xm3; e[1] = xm2; e[2] = xm1;
#pragma unroll
        for (int i = 0; i < 16; ++i) e[3 + i] = bf2f(P[(rb + i) * DIN + c]);
        xm3 = e[16]; xm2 = e[17]; xm1 = e[18];
#pragma unroll
        for (int i = 0; i < 16; i += 2) { xc[i] = cb + cw0 * e[i] + cw1 * e[i + 1] + cw2 * e[i + 2] + cw3 * e[i + 3]; xc[i + 1] = cb + cw0 * e[i + 1] + cw1 * e[i + 2] + cw2 * e[i + 3] + cw3 * e[i + 4];
            const unsigned pk = cvtpk(xc[i], xc[i + 1]); xcb[i * 72 + lane] = (bf16)(pk & 0xffffu); xcb[(i + 1) * 72 + lane] = (bf16)(pk >> 16); }
        asm volatile("s_waitcnt lgkmcnt(0)" ::: "memory"); __builtin_amdgcn_wave_barrier();
        bf16x8 af[2];
#pragma unroll
        for (int ks = 0; ks < 2; ++ks) af[ks] = *(const LAS bf16x8*)(xcb + (lane & 15) * 72 + ks * 32 + (lane >> 4) * 8);
#pragma unroll
        for (int g = 0; g < 2; ++g)
#pragma unroll
            for (int nt = 0; nt < 4; ++nt) { f32x4 acc = {0.f, 0.f, 0.f, 0.f};
#pragma unroll
                for (int ks = 0; ks < 2; ++ks) acc = MFMA16(af[ks], bw[g][nt][ks], acc);
                LAS float* pre = g ? pre_i : pre_r;
#pragma unroll
                for (int j = 0; j < 4; ++j) pre[((lane >> 4) * 4 + j) * 64 + nt * 16 + (lane & 15)] = acc[j]; }
        asm volatile("s_waitcnt lgkmcnt(0)" ::: "memory"); __builtin_amdgcn_wave_barrier();
        float hv[16], pv[16];
#pragma unroll
        for (int i = 0; i < 16; ++i) {
            const float r = sigm(pre_r[i * 64 + lane] + br), ig = sigm(pre_i[i * 64 + lane] + bi);
            const float la = -sp * r, a = __expf(la), x2 = 2.0f * la;
            const float poly = -x2 * (1.0f + x2 * 0.5f * (1.0f + x2 * (1.0f / 3.0f) * (1.0f + x2 * 0.25f * (1.0f + x2 * 0.2f * (1.0f + x2 * (1.0f / 6.0f))))));
            const float om = (x2 > -0.25f) ? poly : (1.0f - a * a);
            h = a * h + __builtin_amdgcn_sqrtf(om) * (ig * xc[i]); pa *= a; hv[i] = h; pv[i] = pa;
        }
        asm volatile("s_waitcnt lgkmcnt(0)" ::: "memory"); __builtin_amdgcn_wave_barrier();
        if (!is_meta) {
#pragma unroll
            for (int i = 0; i < 16; i += 2) { const unsigned hp = cvtpk(hv[i], hv[i + 1]), pp = cvtpk(pv[i], pv[i + 1]);
                HLOC[(rb + i) * DRG + c] = (bf16)(hp & 0xffffu); HLOC[(rb + i + 1) * DRG + c] = (bf16)(hp >> 16);
                PAC[(rb + i) * DRG + c] = (bf16)(pp & 0xffffu); PAC[(rb + i + 1) * DRG + c] = (bf16)(pp >> 16); }
        }
    }
    if (is_meta) hmeta[c] = h; else { Aseg[(size_t)(b * 32 + seg) * DRG + c] = pa; Hseg[(size_t)(b * 32 + seg) * DRG + c] = h; }
}
__device__ __forceinline__ void rg_final(LAS unsigned char* lds, const bf16* P, const bf16* HLOC, const bf16* PAC, const float* Aseg, const float* Hseg, const float* hmeta, const float* gnorm, bf16* Y,
                                         int b, int seg, int tid, int wave, int lane) {
    LAS float* hin = (LAS float*)lds;
    { float h = hmeta[tid]; const float* ap = Aseg + (size_t)b * 32 * DRG + tid; const float* hp = Hseg + (size_t)b * 32 * DRG + tid;
#pragma unroll 8
      for (int j = 0; j < seg; ++j) h = ap[(size_t)j * DRG] * h + hp[(size_t)j * DRG];
      hin[tid] = h; }
    __syncthreads();
    const f32x4 h0 = *(const LAS f32x4*)(hin + 8 * lane), h1 = *(const LAS f32x4*)(hin + 8 * lane + 4);
    const f32x4 g0 = *(const f32x4*)(gnorm + 8 * lane), g1 = *(const f32x4*)(gnorm + 8 * lane + 4);
    const float hi8[8] = {h0.x, h0.y, h0.z, h0.w, h1.x, h1.y, h1.z, h1.w}, gn8[8] = {g0.x, g0.y, g0.z, g0.w, g1.x, g1.y, g1.z, g1.w};
#pragma unroll 4
    for (int i = 0; i < 16; ++i) { const size_t row = (size_t)b * SEQ + (size_t)seg * 128 + wave * 16 + i;
        const v4u hl = *(const v4u*)(HLOC + row * DRG + 8 * lane), pc = *(const v4u*)(PAC + row * DRG + 8 * lane), gv = *(const v4u*)(P + row * DIN + DRG + 8 * lane);
        float y[8]; float s = 0.f;
#pragma unroll
        for (int q = 0; q < 4; ++q) { const float hA = bflo(hl[q]) + bflo(pc[q]) * hi8[2 * q], hB = bfhi(hl[q]) + bfhi(pc[q]) * hi8[2 * q + 1]; const float gA = bflo(gv[q]), gB = bfhi(gv[q]);
            y[2 * q] = gA * sigm(1.5957691216f * (gA + 0.044715f * gA * gA * gA)) * hA; y[2 * q + 1] = gB * sigm(1.5957691216f * (gB + 0.044715f * gB * gB * gB)) * hB;
            s += y[2 * q] * y[2 * q] + y[2 * q + 1] * y[2 * q + 1]; }
        const float rinv = rsqrtf(wave_sum(s) * (1.0f / DRG) + EPS);
        v4u o;
#pragma unroll
        for (int q = 0; q < 4; ++q) o[q] = cvtpk(y[2 * q] * rinv * gn8[2 * q], y[2 * q + 1] * rinv * gn8[2 * q + 1]);
        *(v4u*)(Y + row * DM + 8 * lane) = o; }
}

constexpr int HG_QT = 0, HG_KH = 17408, HG_KHT = 34816, HG_VT = 53248, HG_ST = 71680, HG_AM = 106496, HG_GS = 115712, HG_EB = 117760, HG_SQ = 118272;
template <bool FINAL>
__device__ __forceinline__ void hg_run(LAS unsigned char* lds, const bf16* P, const float* Lb, const float* gnorm, float* Sloc, float* Btot, float* Smeta, bf16* Y,
                                       int b, int h, int sc, bool is_meta, int tid, int wave, int lane) {
    LAS bf16* Qt = (LAS bf16*)(lds + HG_QT); LAS bf16* Kh = (LAS bf16*)(lds + HG_KH); LAS bf16* KhT = (LAS bf16*)(lds + HG_KHT); LAS bf16* VT = (LAS bf16*)(lds + HG_VT);
    LAS bf16* St = (LAS bf16*)(lds + HG_ST); LAS bf16* Am = (LAS bf16*)(lds + HG_AM); LAS float* gsum = (LAS float*)(lds + HG_GS); LAS float* eb = (LAS float*)(lds + HG_EB); LAS float* ssqp = (LAS float*)(lds + HG_SQ);
    const int g = tid >> 7, k = tid & 127, lr = lane & 15, lq = lane >> 4;
    const float lb = 1.0f / (1.0f + __expf(Lb[DRG + h * 128 + k] - Lb[h * 128 + k]));
    const int item = (b * 4 + h) * 8 + sc;
    f32x4 S[8];
#pragma unroll
    for (int tv = 0; tv < 8; ++tv) S[tv] = (f32x4){0.f, 0.f, 0.f, 0.f};
    if (FINAL) {
#pragma unroll
        for (int j = 0; j < 4; ++j) { const int kr = 16 * wave + 4 * lq + j;
#pragma unroll
            for (int tv = 0; tv < 8; ++tv) S[tv][j] = Smeta[(size_t)(h * 128 + kr) * 128 + 16 * tv + lr]; }
        for (int jj = 0; jj < sc; ++jj) { const int it = (b * 4 + h) * 8 + jj;
#pragma unroll
            for (int j = 0; j < 4; ++j) { const int kr = 16 * wave + 4 * lq + j; const float d = __expf(Btot[(size_t)it * 128 + kr]);
#pragma unroll
                for (int tv = 0; tv < 8; ++tv) S[tv][j] = d * S[tv][j] + Sloc[((size_t)it * 128 + kr) * 128 + 16 * tv + lr]; } }
#pragma unroll
        for (int tv = 0; tv < 8; ++tv) { v2u w; w.x = pk2(S[tv][0], S[tv][1]); w.y = pk2(S[tv][2], S[tv][3]); *(LAS v2u*)(St + (16 * tv + lr) * 136 + 16 * wave + 4 * lq) = w; }
    }
    float btot = 0.f;
    const int nch = is_meta ? 1 : 8, nvalid = is_meta ? NMETA : 64;
    for (int ch = 0; ch < nch; ++ch) {
        const size_t rowbase = is_meta ? (size_t)MROWS : (size_t)b * SEQ + (size_t)sc * 512 + (size_t)ch * 64;
        float lfc[16], kk[16], qv[16]; unsigned short vb[16]; float cum = 0.f;
#pragma unroll
        for (int i = 0; i < 16; ++i) { const int s = 16 * g + i; const bool valid = s < nvalid; const size_t row = rowbase + (valid ? s : 0); const bf16* pr = P + row * DIN + h * 128 + k;
            const float hf = bf2f(pr[1536]); const float f = lb + (1.0f - lb) * sigm(hf);
            const float lf = valid ? __logf(f) : 0.f; kk[i] = valid ? (1.0f - f) : 0.f; cum += lf; lfc[i] = cum;
            vb[i] = valid ? pr[2048] : (unsigned short)0;
            if (FINAL) { const float hq = bf2f(pr[1024]); qv[i] = hq * sigm(hq); } }
        gsum[g * 128 + k] = cum;
        __syncthreads();
        float pre = 0.f, tot = 0.f;
#pragma unroll
        for (int gg = 0; gg < 4; ++gg) { const float v = gsum[gg * 128 + k]; tot += v; pre += (gg < g) ? v : 0.f; }
        unsigned kp[8], vp[8];
#pragma unroll
        for (int i = 0; i < 16; i += 2) { const float b0 = pre + lfc[i], b1 = pre + lfc[i + 1];
            const unsigned k0 = f2bf(kk[i] * __expf(-b0)), k1 = f2bf(kk[i + 1] * __expf(-b1));
            kp[i >> 1] = k0 | (k1 << 16); vp[i >> 1] = (unsigned)vb[i] | ((unsigned)vb[i + 1] << 16);
            if (FINAL) { Kh[(16 * g + i) * 136 + k] = (bf16)k0; Kh[(16 * g + i + 1) * 136 + k] = (bf16)k1;
                Qt[(16 * g + i) * 136 + k] = (bf16)f2bf(qv[i] * __expf(b0)); Qt[(16 * g + i + 1) * 136 + k] = (bf16)f2bf(qv[i + 1] * __expf(b1)); } }
        *(LAS v4u*)(KhT + k * 72 + 16 * g) = (v4u){kp[0], kp[1], kp[2], kp[3]}; *(LAS v4u*)(KhT + k * 72 + 16 * g + 8) = (v4u){kp[4], kp[5], kp[6], kp[7]};
        *(LAS v4u*)(VT + k * 72 + 16 * g) = (v4u){vp[0], vp[1], vp[2], vp[3]}; *(LAS v4u*)(VT + k * 72 + 16 * g + 8) = (v4u){vp[4], vp[5], vp[6], vp[7]};
        if (g == 0) eb[k] = __expf(tot);
        btot += tot;
        __syncthreads();
        if (FINAL) {
            { const int tt = wave >> 1;
#pragma unroll
              for (int q = 0; q < 2; ++q) { const int ts = 2 * (wave & 1) + q; f32x4 acc = {0.f, 0.f, 0.f, 0.f};
#pragma unroll
                for (int ks = 0; ks < 4; ++ks) { const bf16x8 a = *(const LAS bf16x8*)(Qt + (16 * tt + lr) * 136 + ks * 32 + lq * 8); const bf16x8 bb = *(const LAS bf16x8*)(Kh + (16 * ts + lr) * 136 + ks * 32 + lq * 8); acc = MFMA16(a, bb, acc); }
#pragma unroll
                for (int j = 0; j < 4; ++j) { const int t = 16 * tt + 4 * lq + j, s = 16 * ts + lr; Am[t * 72 + s] = (bf16)f2bf((s <= t) ? acc[j] : 0.f); } } }
            __syncthreads();
            const int tt = wave & 3, vh = wave >> 2;
            f32x4 o[4];
#pragma unroll
            for (int q = 0; q < 4; ++q) o[q] = (f32x4){0.f, 0.f, 0.f, 0.f};
#pragma unroll
            for (int ks = 0; ks < 4; ++ks) { const bf16x8 a = *(const LAS bf16x8*)(Qt + (16 * tt + lr) * 136 + ks * 32 + lq * 8);
#pragma unroll
                for (int q = 0; q < 4; ++q) { const bf16x8 bb = *(const LAS bf16x8*)(St + (16 * (4 * vh + q) + lr) * 136 + ks * 32 + lq * 8); o[q] = MFMA16(a, bb, o[q]); } }
#pragma unroll
            for (int ks = 0; ks < 2; ++ks) { const bf16x8 a = *(const LAS bf16x8*)(Am + (16 * tt + lr) * 72 + ks * 32 + lq * 8);
#pragma unroll
                for (int q = 0; q < 4; ++q) { const bf16x8 bb = *(const LAS bf16x8*)(VT + (16 * (4 * vh + q) + lr) * 72 + ks * 32 + lq * 8); o[q] = MFMA16(a, bb, o[q]); } }
#pragma unroll
            for (int j = 0; j < 4; ++j) { float p = (o[0][j] * o[0][j] + o[1][j] * o[1][j]) + (o[2][j] * o[2][j] + o[3][j] * o[3][j]);
                p += __shfl_xor(p, 1); p += __shfl_xor(p, 2); p += __shfl_xor(p, 4); p += __shfl_xor(p, 8);
                if (lr == 0) ssqp[vh * 64 + 16 * tt + 4 * lq + j] = p; }
            __syncthreads();
#pragma unroll
            for (int j = 0; j < 4; ++j) { const int t = 16 * tt + 4 * lq + j; const float rinv = rsqrtf((ssqp[t] + ssqp[64 + t]) * (1.0f / 128.0f) + EPS); const size_t row = rowbase + t;
#pragma unroll
                for (int q = 0; q < 4; ++q) { const int v = 16 * (4 * vh + q) + lr; const float hgv = bf2f(P[row * DIN + 2560 + h * 128 + v]);
                    Y[row * DM + DRG + h * 128 + v] = (bf16)f2bf(o[q][j] * rinv * gnorm[v] * (hgv * sigm(hgv))); } }
        }
#pragma unroll
        for (int ks = 0; ks < 2; ++ks) { const bf16x8 a = *(const LAS bf16x8*)(KhT + (16 * wave + lr) * 72 + ks * 32 + lq * 8);
#pragma unroll
            for (int tv = 0; tv < 8; ++tv) { const bf16x8 bb = *(const LAS bf16x8*)(VT + (16 * tv + lr) * 72 + ks * 32 + lq * 8); S[tv] = MFMA16(a, bb, S[tv]); } }
#pragma unroll
        for (int j = 0; j < 4; ++j) { const float e = eb[16 * wave + 4 * lq + j];
#pragma unroll
            for (int tv = 0; tv < 8; ++tv) S[tv][j] *= e; }
        if (FINAL) {
#pragma unroll
            for (int tv = 0; tv < 8; ++tv) { v2u w; w.x = pk2(S[tv][0], S[tv][1]); w.y = pk2(S[tv][2], S[tv][3]); *(LAS v2u*)(St + (16 * tv + lr) * 136 + 16 * wave + 4 * lq) = w; }
        }
    }
    if (!FINAL) {
        float* dst = is_meta ? (Smeta + (size_t)h * 128 * 128) : (Sloc + (size_t)item * 128 * 128);
#pragma unroll
        for (int j = 0; j < 4; ++j) { const int kr = 16 * wave + 4 * lq + j;
#pragma unroll
            for (int tv = 0; tv < 8; ++tv) dst[(size_t)kr * 128 + 16 * tv + lr] = S[tv][j]; }
        if (!is_meta && g == 0) Btot[(size_t)item * 128 + k] = btot;
    }
}

struct Args { const float* in[19]; float* out; unsigned char* ws; int ph_lo, ph_hi; };
__global__ void __launch_bounds__(512, 2) fwd_megakernel(Args args) {
    extern __shared__ __attribute__((aligned(16))) unsigned char lds_raw[];
    LAS unsigned char* lds = (LAS unsigned char*)lds_raw;
    cg::grid_group grid = cg::this_grid();
    const int tid = threadIdx.x, lane = tid & 63, wave = __builtin_amdgcn_readfirstlane(tid >> 6);
    const int G = gridDim.x, bx = blockIdx.x;
    unsigned char* ws = args.ws;
    const float* x = args.in[0]; const float* meta = args.in[1]; const float* mix_g = args.in[2]; const float* w_in = args.in[3];
    const float* conv_w = args.in[4]; const float* conv_b = args.in[5]; const float* w_rg = args.in[6]; const float* b_rg = args.in[7];
    const float* w_ig = args.in[8]; const float* b_ig = args.in[9]; const float* lam = args.in[10]; const float* rg_g = args.in[11];
    const float* hg_lb = args.in[12]; const float* hg_g = args.in[13]; const float* w_out = args.in[14]; const float* ffn_g = args.in[15];
    const float* w_gu = args.in[16]; const float* w_down = args.in[17]; const float* fin_g = args.in[18];
    bf16* Win_t = (bf16*)(ws + WS_WIN); bf16* Wo_t = (bf16*)(ws + WS_WO); bf16* Wgu_t = (bf16*)(ws + WS_WGU); bf16* Wd_t = (bf16*)(ws + WS_WD); bf16* Wg_t = (bf16*)(ws + WS_WG);
    float* Aseg = (float*)(ws + WS_RGA); float* Hseg = (float*)(ws + WS_RGH); float* hmeta = (float*)(ws + WS_HM); float* Btot = (float*)(ws + WS_BT); float* Smeta = (float*)(ws + WS_SM);
    float* SSQ1 = (float*)(ws + WS_SSQ1); float* SSQ2 = (float*)(ws + WS_SSQ2); float* Sloc = (float*)(ws + WS_SL);
    bf16* XN = (bf16*)(ws + WS_XN); bf16* H1B = (bf16*)(ws + WS_XN); bf16* HLOC = (bf16*)(ws + WS_XN); bf16* PAC = (bf16*)(ws + WS_XN + 32 * MiB); bf16* Y = (bf16*)(ws + WS_Y); bf16* P = (bf16*)(ws + WS_P); bf16* ACT = (bf16*)(ws + WS_P);
    float* out = args.out;
    const int lo = args.ph_lo, hi = args.ph_hi;
#define IN(k) (lo <= (k) && (k) < hi)
#define SEAM(k) do { if (IN(k) && IN((k) + 1)) grid.sync(); } while (0)

    REP(0) if (IN(0) && !(SKIPMASK & 1)) { if (rep_) grid.sync();
        const int gw = bx * 8 + wave, NGW = G * 8;
        if (bx < 24) {
            LAS float* um = (LAS float*)lds;
            LAS float* red = (LAS float*)(lds + 65536);
#pragma unroll
            for (int r = 0; r < 2; ++r) { const int m = wave * 2 + r; const f32x4* xr = (const f32x4*)(meta + (size_t)m * DM) + lane; const f32x4* gr = (const f32x4*)mix_g + lane;
                f32x4 v[4]; float s = 0.f;
#pragma unroll
                for (int j = 0; j < 4; ++j) { v[j] = xr[64 * j]; s += (v[j].x * v[j].x + v[j].y * v[j].y) + (v[j].z * v[j].z + v[j].w * v[j].w); }
                const float rinv = rsqrtf(wave_sum(s) * (1.f / DM) + EPS);
#pragma unroll
                for (int j = 0; j < 4; ++j) { const f32x4 gg = gr[64 * j]; const int k0 = 256 * j + 4 * lane;
                    um[(k0 + 0) * 16 + m] = v[j].x * rinv * gg.x; um[(k0 + 1) * 16 + m] = v[j].y * rinv * gg.y; um[(k0 + 2) * 16 + m] = v[j].z * rinv * gg.z; um[(k0 + 3) * 16 + m] = v[j].w * rinv * gg.w; } }
            __syncthreads();
            const int kg = tid >> 7, nl = tid & 127, n = bx * 128 + nl;
            float acc[16];
#pragma unroll
            for (int m = 0; m < 16; ++m) acc[m] = 0.f;
#pragma unroll 8
            for (int kk = kg * 256; kk < kg * 256 + 256; ++kk) { const float w = w_in[(size_t)kk * DIN + n]; const LAS f32x4* u4 = (const LAS f32x4*)(um + kk * 16);
#pragma unroll
                for (int q = 0; q < 4; ++q) { const f32x4 uv = u4[q]; acc[4 * q + 0] += w * uv.x; acc[4 * q + 1] += w * uv.y; acc[4 * q + 2] += w * uv.z; acc[4 * q + 3] += w * uv.w; } }
#pragma unroll
            for (int m = 0; m < 16; ++m) red[(kg * 16 + m) * 128 + nl] = acc[m];
            __syncthreads();
            for (int o = tid; o < 2048; o += 512) { const int m = o >> 7, n2 = o & 127;
                const float s = (red[(0 * 16 + m) * 128 + n2] + red[(1 * 16 + m) * 128 + n2]) + (red[(2 * 16 + m) * 128 + n2] + red[(3 * 16 + m) * 128 + n2]);
                P[(size_t)(MROWS + m) * DIN + bx * 128 + n2] = (bf16)f2bf(s); }
            __syncthreads();
        }
        LAS float* scr = (LAS float*)(lds + wave * 16384);
        constexpr int I_IN = (DM / 64) * (DIN / 32), I_O = (DM / 64) * (DM / 32), I_GU = (DM / 64) * (2 * DFF / 32), I_D = (DFF / 64) * (DM / 32);
        constexpr int NITEMS = I_IN + I_O + I_GU + I_D;
        for (int it = gw; it < NITEMS; it += NGW) {
            int r = it;
            if (r < I_IN) { p0_transpose_item(w_in, DM, DIN, Win_t, scr, r, lane, 0, nullptr); continue; } r -= I_IN;
            if (r < I_O) { p0_transpose_item(w_out, DM, DM, Wo_t, scr, r, lane, 0, nullptr); continue; } r -= I_O;
            if (r < I_GU) { p0_transpose_item(w_gu, DM, 2 * DFF, Wgu_t, scr, r, lane, 1, ffn_g); continue; } r -= I_GU;
            p0_transpose_item(w_down, DFF, DM, Wd_t, scr, r, lane, 0, nullptr);
        }
        for (int i = bx * 512 + tid; i < 2 * 8 * 64 * 64; i += G * 512) {
            const int gt = i >> 15, hh = (i >> 12) & 7, j = (i >> 6) & 63, ii = i & 63;
            Wg_t[i] = (bf16)f2bf((gt ? w_ig : w_rg)[hh * 4096 + ii * 64 + j]); }
        for (int m = gw; m < MROWS; m += NGW) rms_row_to_bf16(x + (size_t)m * DM, mix_g, XN + (size_t)m * DM, lane);
    }
    SEAM(0);
    REP(1) if (IN(1) && !(SKIPMASK & 2)) { if (rep_) grid.sync();
        pg8::Gemm g{XN, Win_t, MROWS, DIN, DM}; pg8::StaticOrder S; S.init(MROWS, DIN, G, bx);
        pg8::EpiP E{P, DIN};
        pg8::gemm_phase<pg8::EpiP, pg8::StaticOrder, true, true>(lds, g, S, E);
    }
    SEAM(1);
    REP(2) if (IN(2) && !(SKIPMASK & 4)) { if (rep_) grid.sync();
        for (int it = bx; it < 256; it += G) {
            int wv = wave, ln = lane, td = tid; asm volatile("" : "+s"(wv), "+v"(ln), "+v"(td));
#ifndef NO_RG
            rg_scan(lds, P, Wg_t, conv_w, conv_b, b_rg, b_ig, lam, Aseg, Hseg, hmeta, HLOC, PAC, it >> 5, it & 31, false, wv, ln);
            if (it == 255) rg_scan(lds, P, Wg_t, conv_w, conv_b, b_rg, b_ig, lam, Aseg, Hseg, hmeta, HLOC, PAC, 0, 0, true, wv, ln);
#endif
            __syncthreads();
#ifndef NO_HG
            hg_run<false>(lds, P, hg_lb, hg_g, Sloc, Btot, Smeta, Y, it >> 5, (it >> 3) & 3, it & 7, false, td, wv, ln);
            __syncthreads();
            if (it < 4) { hg_run<false>(lds, P, hg_lb, hg_g, Sloc, Btot, Smeta, Y, 0, it, 0, true, td, wv, ln); __syncthreads(); }
#endif
        }
    }
    SEAM(2);
    REP(3) if (IN(3) && !(SKIPMASK & 8)) { if (rep_) grid.sync();
        for (int it = bx; it < 256; it += G) {
            int wv = wave, ln = lane, td = tid; asm volatile("" : "+s"(wv), "+v"(ln), "+v"(td));
#ifndef NO_RG
            rg_final(lds, P, HLOC, PAC, Aseg, Hseg, hmeta, rg_g, Y, it >> 5, it & 31, td, wv, ln);
            __syncthreads();
#endif
#ifndef NO_HG
            hg_run<true>(lds, P, hg_lb, hg_g, Sloc, Btot, Smeta, Y, it >> 5, (it >> 3) & 3, it & 7, false, td, wv, ln);
            __syncthreads();
#endif
        }
    }
    SEAM(3);
    REP(4) if (IN(4) && !(SKIPMASK & 16)) { if (rep_) grid.sync();
        pg8::Gemm g{Y, Wo_t, MROWS, DM, DM}; pg8::StaticOrder S; S.init(MROWS, DM, G, bx);
        pg8::EpiOut E{x, H1B, SSQ1};
        pg8::gemm_phase<pg8::EpiOut, pg8::StaticOrder, true, true>(lds, g, S, E);
    }
    SEAM(4);
    REP(5) if (IN(5) && !(SKIPMASK & 32)) { if (rep_) grid.sync();
        pg8::Gemm g{H1B, Wgu_t, MROWS, 2 * DFF, DM}; pg8::StaticOrder S; S.init(MROWS, 2 * DFF, G, bx);
        pg8::EpiGU E{SSQ1, ACT};
        pg8::gemm_phase<pg8::EpiGU, pg8::StaticOrder, true, true>(lds, g, S, E);
    }
    SEAM(5);
    REP(6) if (IN(6) && !(SKIPMASK & 64)) { if (rep_) grid.sync();
        pg8::Gemm g{ACT, Wd_t, MROWS, DM, DFF}; pg8::StaticOrder S; S.init(MROWS, DM, G, bx);
        pg8::EpiDown E{H1B, SSQ2};
        pg8::gemm_phase<pg8::EpiDown, pg8::StaticOrder, true, true>(lds, g, S, E);
    }
    SEAM(6);
    REP(7) if (IN(7) && !(SKIPMASK & 128)) { if (rep_) grid.sync();
        const int gw = bx * 8 + wave, NGW = G * 8;
        for (int m = gw; m < MROWS; m += NGW) {
            const float sv = (lane < 16) ? SSQ2[(size_t)m * 16 + lane] : 0.f;
            const float rinv = rsqrtf(wave_sum(sv) * (1.f / DM) + EPS);
            const float* gp = fin_g;
#pragma unroll
            for (int j = 0; j < 2; ++j) { const int c0 = (64 * j + lane) * 8; const v4u hv = *(const v4u*)(H1B + (size_t)m * DM + c0); const f32x4 ga = *(const f32x4*)(gp + c0), gb = *(const f32x4*)(gp + c0 + 4);
                f32x4 oa = {bflo(hv.x) * rinv * ga.x, bfhi(hv.x) * rinv * ga.y, bflo(hv.y) * rinv * ga.z, bfhi(hv.y) * rinv * ga.w};
                f32x4 ob = {bflo(hv.z) * rinv * gb.x, bfhi(hv.z) * rinv * gb.y, bflo(hv.w) * rinv * gb.z, bfhi(hv.w) * rinv * gb.w};
                *(f32x4*)(out + (size_t)m * DM + c0) = oa; *(f32x4*)(out + (size_t)m * DM + c0 + 4) = ob; }
        }
    }
#undef IN
#undef SEAM
}

extern "C" void kernel_launch(void* const* d_in, const int* in_sizes, int n_in, void* d_out, int out_size, void* d_ws, size_t ws_size, hipStream_t stream) {
    static int grid = 0;
    if (grid == 0) {
        if (n_in != 19 || in_sizes[0] != MROWS * DM || out_size != MROWS * DM || ws_size < WS_END) { fprintf(stderr, "kernel_launch: unexpected shapes (n_in %d, in0 %d, out %d, ws %zu)\n", n_in, n_in > 0 ? in_sizes[0] : -1, out_size, ws_size); grid = -1; return; }
        int dev = 0, cus = 0, per_cu = 0;
        hipGetDevice(&dev); hipDeviceGetAttribute(&cus, hipDeviceAttributeMultiprocessorCount, dev);
        if (hipFuncSetAttribute((const void*)fwd_megakernel, hipFuncAttributeMaxDynamicSharedMemorySize, LDS_BYTES) != hipSuccess) { fprintf(stderr, "kernel_launch: hipFuncSetAttribute failed\n"); grid = -1; return; }
        if (hipOccupancyMaxActiveBlocksPerMultiprocessor(&per_cu, (const void*)fwd_megakernel, 512, LDS_BYTES) != hipSuccess || per_cu < 1) { fprintf(stderr, "kernel_launch: occupancy query gave %d\n", per_cu); per_cu = 1; }
        (void)hipGetLastError();
        grid = cus * per_cu;
        fprintf(stderr, "kernel_launch: grid %d (cus %d x %d)\n", grid, cus, per_cu);
    }
    if (grid < 0) return;
    Args a{};
    for (int i = 0; i < 19; ++i) a.in[i] = (const float*)d_in[i];
    a.out = (float*)d_out; a.ws = (unsigned char*)d_ws;
#if MK_N_LAUNCHES == 1
    a.ph_lo = 0; a.ph_hi = NPH;
    void* kargs[] = {&a};
    hipError_t e = hipLaunchCooperativeKernel((const void*)fwd_megakernel, dim3(grid), dim3(512), kargs, LDS_BYTES, stream);
    if (e != hipSuccess) fprintf(stderr, "kernel_launch: cooperative launch failed: %s (grid %d)\n", hipGetErrorString(e), grid);
#else
    for (int p = 0; p < NPH; ++p) { a.ph_lo = p; a.ph_hi = p + 1; hipLaunchKernelGGL(fwd_megakernel, dim3(grid), dim3(512), LDS_BYTES, stream, a); }
#endif
}
```

```cpp
#include <hip/hip_runtime.h>
#include <hip/hip_cooperative_groups.h>
#include <cstdio>
#include <cstdint>
namespace cg = cooperative_groups;
namespace pg8 {
#define PG8_LAS __attribute__((address_space(3)))
typedef unsigned short bf16_t;
typedef short bf16x8 __attribute__((ext_vector_type(8)));
typedef float f32x4 __attribute__((ext_vector_type(4)));
typedef unsigned u32x4 __attribute__((ext_vector_type(4)));
constexpr int BM = 256, BK = 64, HALF = 128, HTB = HALF * BK * 2  , STAGE_BYTES = 8 * HTB, NXCD = 8, WGM = 8;

__host__ __device__ __forceinline__ int lds_byte(int r, int c) { const int st = (r >> 4) * 2 + (c >> 5), rr = r & 15, cc = c & 31, ob = rr * 64 + cc * 2; return st * 1024 + (ob ^ (((ob >> 9) & 1) << 5)); }
__host__ __device__ __forceinline__ void stage_rc(int b, int& R, int& C) { const int st = b / 1024, sb = b % 1024, swz = sb ^ (((sb >> 9) & 1) << 5); R = (st >> 1) * 16 + swz / 64; C = (st & 1) * 32 + (swz % 64) / 2; }
__host__ __device__ __forceinline__ int perm32(int rho) { const int n = rho >> 4, i = rho & 15; return 8 * (i >> 2) + 4 * n + (i & 3); }

struct Unit { int pm, pn; };
struct Gemm { const bf16_t* A; const bf16_t* Bt; int M, N, K; };

struct StaticOrder {
    int nM, nN, nwg, G, c;
    __host__ __device__ void init(int M, int N, int G_, int c_) { nM = M / BM; nN = N / BM; nwg = nM * nN; G = G_; c = c_; }
    __host__ __device__ bool next(int i, Unit& u) const {
        const long L = (long)i * G + c; if (L >= nwg) return false;
        int wgid = (int)L; { const int q = nwg / NXCD, r = nwg % NXCD, xcd = wgid % NXCD, off = wgid / NXCD; wgid = (xcd < r ? xcd * (q + 1) : r * (q + 1) + (xcd - r) * q) + off; }
        const int nig = WGM * nN, gid = wgid / nig, fm = gid * WGM, gsz = (nM - fm) < WGM ? (nM - fm) : WGM;
        u.pm = fm + ((wgid % nig) % gsz); u.pn = (wgid % nig) / gsz; return true;
    }
    __device__ __forceinline__ void a_ready(const Unit&) const {}
    __device__ __forceinline__ void done(const Unit&) const {}
};

__device__ __forceinline__ unsigned cvt_pk_bf16(float lo, float hi) { unsigned r; asm volatile("v_cvt_pk_bf16_f32 %0, %1, %2" : "=v"(r) : "v"(lo), "v"(hi)); return r; }
typedef unsigned u32x2 __attribute__((ext_vector_type(2)));
struct EpiP {
    static constexpr bool PERM = true, AFTER_DRAIN = false;
    bf16_t* O; int ldc;
    __device__ __forceinline__ void operator()(const f32x4 (&acc)[2][2][4][2], const Unit& u, int wr, int wc, int fr, int fq) const {
        const int row0 = u.pm * BM + wr * 64 + fr, col0 = u.pn * BM + wc * 32 + 8 * fq;
#pragma unroll
        for (int ai = 0; ai < 2; ++ai)
#pragma unroll
            for (int m = 0; m < 4; ++m) { bf16_t* rowp = O + (size_t)(row0 + ai * HALF + m * 16) * ldc + col0;
#pragma unroll
                for (int bj = 0; bj < 2; ++bj) { const f32x4 v0 = acc[ai][bj][m][0], v1 = acc[ai][bj][m][1];
                    u32x4 w; w.x = cvt_pk_bf16(v0[0], v0[1]); w.y = cvt_pk_bf16(v0[2], v0[3]); w.z = cvt_pk_bf16(v1[0], v1[1]); w.w = cvt_pk_bf16(v1[2], v1[3]);
                    *(u32x4*)(rowp + bj * HALF) = w; } }
    }
};
struct EpiOut {
    static constexpr bool PERM = false, AFTER_DRAIN = false;
    const float* x; bf16_t* hb; float* ssq;
    __device__ __forceinline__ void operator()(const f32x4 (&acc)[2][2][4][2], const Unit& u, int wr, int wc, int fr, int fq) const {
        const int row0 = u.pm * BM + wr * 64 + fr, col0 = u.pn * BM + wc * 32 + 4 * fq;
#pragma unroll
        for (int ai = 0; ai < 2; ++ai)
#pragma unroll
            for (int m = 0; m < 4; ++m) { const int row = row0 + ai * HALF + m * 16; const size_t off = (size_t)row * 1024 + col0; float s = 0.f;
#pragma unroll
                for (int bj = 0; bj < 2; ++bj)
#pragma unroll
                    for (int n = 0; n < 2; ++n) { const size_t o = off + bj * HALF + n * 16; const f32x4 xv = *(const f32x4*)(x + o); const f32x4 hv = xv + acc[ai][bj][m][n];
                        s += (hv[0] * hv[0] + hv[1] * hv[1]) + (hv[2] * hv[2] + hv[3] * hv[3]);
                        u32x2 w; w.x = cvt_pk_bf16(hv[0], hv[1]); w.y = cvt_pk_bf16(hv[2], hv[3]); *(u32x2*)(hb + o) = w; }
                s += __shfl_xor(s, 16); s += __shfl_xor(s, 32);
                if (fq == 0) ssq[(size_t)row * 16 + u.pn * 4 + wc] = s; }
    }
};
struct EpiGU {
    static constexpr bool PERM = true, AFTER_DRAIN = false;
    const float* ssq; bf16_t* act;
    __device__ __forceinline__ void operator()(const f32x4 (&acc)[2][2][4][2], const Unit& u, int wr, int wc, int fr, int fq) const {
        const int row0 = u.pm * BM + wr * 64 + fr, col0 = u.pn * 128 + wc * 32 + 8 * fq;
#pragma unroll
        for (int ai = 0; ai < 2; ++ai)
#pragma unroll
            for (int m = 0; m < 4; ++m) { const int row = row0 + ai * HALF + m * 16; const f32x4* sp = (const f32x4*)(ssq + (size_t)row * 16);
                const f32x4 s0 = sp[0], s1 = sp[1], s2 = sp[2], s3 = sp[3]; const f32x4 st = (s0 + s1) + (s2 + s3);
                const float rinv = rsqrtf(((st[0] + st[1]) + (st[2] + st[3])) * (1.0f / 1024.0f) + 1e-6f);
                float a[8];
#pragma unroll
                for (int n = 0; n < 2; ++n)
#pragma unroll
                    for (int j = 0; j < 4; ++j) { const float g = acc[ai][0][m][n][j] * rinv, up = acc[ai][1][m][n][j] * rinv; a[4 * n + j] = g * __builtin_amdgcn_rcpf(1.0f + __expf(-g)) * up; }
                u32x4 w; w.x = cvt_pk_bf16(a[0], a[1]); w.y = cvt_pk_bf16(a[2], a[3]); w.z = cvt_pk_bf16(a[4], a[5]); w.w = cvt_pk_bf16(a[6], a[7]);
                *(u32x4*)(act + (size_t)row * 2816 + col0) = w; }
    }
};
struct EpiDown {
    static constexpr bool PERM = false, AFTER_DRAIN = false;
    bf16_t* hb; float* ssq;
    __device__ __forceinline__ void operator()(const f32x4 (&acc)[2][2][4][2], const Unit& u, int wr, int wc, int fr, int fq) const {
        const int row0 = u.pm * BM + wr * 64 + fr, col0 = u.pn * BM + wc * 32 + 4 * fq;
#pragma unroll
        for (int ai = 0; ai < 2; ++ai)
#pragma unroll
            for (int m = 0; m < 4; ++m) { const int row = row0 + ai * HALF + m * 16; const size_t off = (size_t)row * 1024 + col0; float s = 0.f;
#pragma unroll
                for (int bj = 0; bj < 2; ++bj)
#pragma unroll
                    for (int n = 0; n < 2; ++n) { const size_t o = off + bj * HALF + n * 16; const u32x2 xb = *(const u32x2*)(hb + o); const f32x4 xv = {__uint_as_float(xb.x << 16), __uint_as_float(xb.x & 0xffff0000u), __uint_as_float(xb.y << 16), __uint_as_float(xb.y & 0xffff0000u)}; const f32x4 hv = xv + acc[ai][bj][m][n];
                        s += (hv[0] * hv[0] + hv[1] * hv[1]) + (hv[2] * hv[2] + hv[3] * hv[3]);
                        u32x2 w; w.x = cvt_pk_bf16(hv[0], hv[1]); w.y = cvt_pk_bf16(hv[2], hv[3]); *(u32x2*)(hb + o) = w; }
                s += __shfl_xor(s, 16); s += __shfl_xor(s, 32);
                if (fq == 0) ssq[(size_t)row * 16 + u.pn * 4 + wc] = s; }
    }
};
template <class Epi, class Sched, bool ALIGN_EPI = false, bool SP2 = false>
__device__ __forceinline__ void gemm_phase(PG8_LAS unsigned char* lds, const Gemm g, const Sched& S, const Epi& E) {
    const int tid = threadIdx.x, wid = __builtin_amdgcn_readfirstlane(tid >> 6), lane = tid & 63, wr = wid >> 2, wc = wid & 3, fr = lane & 15, fq = lane >> 4;
    const int K = g.K, nt = K / BK;
    unsigned voffA[2], voffB[2];
#pragma unroll
    for (int i = 0; i < 2; ++i) { int R, C; stage_rc(tid * 16 + i * 8192, R, C); const int Rb = Epi::PERM ? ((R & ~31) + perm32(R & 31)) : R;
        voffA[i] = (unsigned)(R * K + C) * 2u; voffB[i] = (unsigned)(Rb * K + C) * 2u; }
    const size_t kstep = (size_t)(BK * 2);
    const size_t hstep = (size_t)HALF * K * 2;
    const size_t tstep = 2 * hstep;
    const unsigned ldsw = (unsigned)wid * 1024u;
    const int aoff = lds_byte(wr * 64 + fr, fq * 8), boff = lds_byte(wc * 32 + fr, fq * 8);
#define PG8_SA(b, h) (((b) * 2 + (h)) * HTB)
#define PG8_SB(b, h) ((4 + (b) * 2 + (h)) * HTB)
#define PG8_STAGE(bufoff, gbase, voff) do { _Pragma("unroll") for (int _i = 0; _i < 2; ++_i) \
        __builtin_amdgcn_global_load_lds((const unsigned*)((const char*)(gbase) + (voff)[_i]), (PG8_LAS unsigned*)(lds + (bufoff) + ldsw + _i * 8192), 16, 0, 0); } while (0)
#define PG8_LDA(dst, b, h) do { _Pragma("unroll") for (int m = 0; m < 4; ++m) _Pragma("unroll") for (int k = 0; k < 2; ++k) dst[m][k] = *(const PG8_LAS bf16x8*)(lds + PG8_SA(b, h) + aoff + m * 2048 + k * 1024); } while (0)
#define PG8_LDB(dst, b, h) do { _Pragma("unroll") for (int n = 0; n < 2; ++n) _Pragma("unroll") for (int k = 0; k < 2; ++k) dst[n][k] = *(const PG8_LAS bf16x8*)(lds + PG8_SB(b, h) + boff + n * 2048 + k * 1024); } while (0)
#define PG8_MMA(ai, bj, At, Bt) do { __builtin_amdgcn_s_setprio(1); _Pragma("unroll") for (int m = 0; m < 4; ++m) _Pragma("unroll") for (int n = 0; n < 2; ++n) _Pragma("unroll") for (int k = 0; k < 2; ++k) \
        acc[ai][bj][m][n] = __builtin_amdgcn_mfma_f32_16x16x32_bf16(Bt[n][k], At[m][k], acc[ai][bj][m][n], 0, 0, 0); __builtin_amdgcn_s_setprio(0); } while (0)
#define PG8_WAIT_V(n) asm volatile("s_waitcnt vmcnt(" #n ")" ::: "memory")
#define PG8_WAIT_L(n) asm volatile("s_waitcnt lgkmcnt(" #n ")" ::: "memory")
#define PG8_BAR __builtin_amdgcn_s_barrier()
#define PG8_SCHED __builtin_amdgcn_sched_barrier(0)
    Unit cur, nxt; int ui = 0;
    if (!S.next(0, cur)) return;
    f32x4 acc[2][2][4][2];
#pragma unroll
    for (int a = 0; a < 2; ++a)
#pragma unroll
        for (int b = 0; b < 2; ++b)
#pragma unroll
            for (int m = 0; m < 4; ++m)
#pragma unroll
                for (int n = 0; n < 2; ++n) acc[a][b][m][n] = (f32x4){0.f, 0.f, 0.f, 0.f};
    bf16x8 At[4][2], B0[2][2], B1[2][2];
    const char* cA = (const char*)g.A + (size_t)cur.pm * tstep; const char* cB = (const char*)g.Bt + (size_t)cur.pn * tstep;
    S.a_ready(cur);
    if constexpr (SP2) {
        PG8_STAGE(PG8_SB(0, 0), cB, voffB); PG8_STAGE(PG8_SB(0, 1), cB + hstep, voffB); PG8_STAGE(PG8_SA(0, 0), cA, voffA); PG8_STAGE(PG8_SA(0, 1), cA + hstep, voffA);
        if (wr == 1) PG8_BAR;
        PG8_WAIT_V(2); PG8_BAR;
        PG8_STAGE(PG8_SB(1, 0), cB + kstep, voffB); PG8_STAGE(PG8_SA(1, 0), cA + kstep, voffA); PG8_STAGE(PG8_SB(1, 1), cB + hstep + kstep, voffB);
        PG8_WAIT_V(6); PG8_BAR;
    } else {
        PG8_STAGE(PG8_SB(0, 0), cB, voffB); PG8_STAGE(PG8_SA(0, 0), cA, voffA); PG8_STAGE(PG8_SB(0, 1), cB + hstep, voffB); PG8_STAGE(PG8_SA(0, 1), cA + hstep, voffA);
        if (wr == 1) PG8_BAR;
        PG8_WAIT_V(4); PG8_BAR;
        PG8_STAGE(PG8_SB(1, 0), cB + kstep, voffB); PG8_STAGE(PG8_SA(1, 0), cA + kstep, voffA); PG8_STAGE(PG8_SB(1, 1), cB + hstep + kstep, voffB);
        PG8_WAIT_V(6); PG8_BAR;
    }
    for (;;) {
        const bool has_next = S.next(ui + 1, nxt);
        const char* nA = has_next ? (const char*)g.A + (size_t)nxt.pm * tstep : cA; const char* nB = has_next ? (const char*)g.Bt + (size_t)nxt.pn * tstep : cB;
        for (int t = 0; t < nt; t += 2) {
            const bool last = (t == nt - 2);
            const char* a1 = cA + (size_t)(t + 1) * kstep;
            const char* a2 = last ? nA : cA + (size_t)(t + 2) * kstep; const char* b2 = last ? nB : cB + (size_t)(t + 2) * kstep;
            const char* a3 = a2 + kstep; const char* b3 = b2 + kstep;
            if (last && has_next) S.a_ready(nxt);
            if constexpr (SP2) {
            PG8_LDB(B0, 0, 0); PG8_LDB(B1, 0, 1); PG8_SCHED; PG8_LDA(At, 0, 0); PG8_STAGE(PG8_SA(1, 1), a1 + hstep, voffA);
            PG8_WAIT_V(8); PG8_WAIT_L(0); PG8_BAR; PG8_MMA(0, 0, At, B0); PG8_MMA(0, 1, At, B1); PG8_BAR; PG8_SCHED;
            PG8_LDA(At, 0, 1); PG8_STAGE(PG8_SB(0, 0), b2, voffB); PG8_STAGE(PG8_SB(0, 1), b2 + hstep, voffB); PG8_STAGE(PG8_SA(0, 0), a2, voffA);
            PG8_WAIT_V(8); PG8_WAIT_L(0); PG8_BAR; PG8_MMA(1, 0, At, B0); PG8_MMA(1, 1, At, B1); PG8_BAR; PG8_SCHED;
            PG8_LDB(B0, 1, 0); PG8_LDB(B1, 1, 1); PG8_SCHED; PG8_LDA(At, 1, 0); PG8_STAGE(PG8_SA(0, 1), a2 + hstep, voffA);
            PG8_WAIT_V(8); PG8_WAIT_L(0); PG8_BAR; PG8_MMA(0, 0, At, B0); PG8_MMA(0, 1, At, B1); PG8_BAR; PG8_SCHED;
            PG8_LDA(At, 1, 1); PG8_STAGE(PG8_SB(1, 0), b3, voffB); PG8_STAGE(PG8_SB(1, 1), b3 + hstep, voffB); PG8_STAGE(PG8_SA(1, 0), a3, voffA);
            PG8_WAIT_V(8); PG8_WAIT_L(0); PG8_BAR; PG8_MMA(1, 0, At, B0); PG8_MMA(1, 1, At, B1); PG8_BAR; PG8_SCHED;
            } else {
            PG8_LDB(B0, 0, 0); PG8_SCHED; PG8_LDA(At, 0, 0); PG8_STAGE(PG8_SA(1, 1), a1 + hstep, voffA);
            PG8_WAIT_L(8); PG8_BAR; PG8_WAIT_L(0); PG8_MMA(0, 0, At, B0); PG8_BAR; PG8_SCHED;
            PG8_LDB(B1, 0, 1); PG8_STAGE(PG8_SB(0, 0), b2, voffB);
            PG8_BAR; PG8_WAIT_L(0); PG8_MMA(0, 1, At, B1); PG8_BAR;
            PG8_LDA(At, 0, 1); PG8_STAGE(PG8_SA(0, 0), a2, voffA);
            PG8_BAR; PG8_WAIT_L(0); PG8_MMA(1, 0, At, B0); PG8_BAR; PG8_SCHED;
            PG8_STAGE(PG8_SB(0, 1), b2 + hstep, voffB);
            PG8_WAIT_V(6); PG8_BAR; PG8_MMA(1, 1, At, B1); PG8_BAR;
            PG8_LDB(B0, 1, 0); PG8_SCHED; PG8_LDA(At, 1, 0); PG8_STAGE(PG8_SA(0, 1), a2 + hstep, voffA);
            PG8_WAIT_L(8); PG8_BAR; PG8_WAIT_L(0); PG8_MMA(0, 0, At, B0); PG8_BAR; PG8_SCHED;
            PG8_LDB(B1, 1, 1); PG8_STAGE(PG8_SB(1, 0), b3, voffB);
            PG8_BAR; PG8_WAIT_L(0); PG8_MMA(0, 1, At, B1); PG8_BAR;
            PG8_LDA(At, 1, 1); PG8_STAGE(PG8_SA(1, 0), a3, voffA);
            PG8_BAR; PG8_WAIT_L(0); PG8_MMA(1, 0, At, B0); PG8_BAR; PG8_SCHED;
            PG8_STAGE(PG8_SB(1, 1), b3 + hstep, voffB);
            PG8_WAIT_V(6); PG8_BAR; PG8_MMA(1, 1, At, B1); PG8_BAR;
            }
        }
        if constexpr (ALIGN_EPI) { if (wr == 0) PG8_BAR; }
        if constexpr (!Epi::AFTER_DRAIN) { E(acc, cur, wr, wc, fr, fq); S.done(cur); }
        if (!has_next) break;
#pragma unroll
        for (int a = 0; a < 2; ++a)
#pragma unroll
            for (int b = 0; b < 2; ++b)
#pragma unroll
                for (int m = 0; m < 4; ++m)
#pragma unroll
                    for (int n = 0; n < 2; ++n) acc[a][b][m][n] = (f32x4){0.f, 0.f, 0.f, 0.f};
        cur = nxt; cA = nA; cB = nB; ++ui;
        if constexpr (ALIGN_EPI) { if (wr == 1) PG8_BAR; }
    }
    PG8_WAIT_V(0);
    if constexpr (!ALIGN_EPI) { if (wr == 0) PG8_BAR; }
    PG8_BAR;
    if constexpr (Epi::AFTER_DRAIN) { E.fused(acc, cur, wr, wc, fr, fq, lds, wid, lane); S.done(cur); }
#undef PG8_SA
#undef PG8_SB
#undef PG8_STAGE
#undef PG8_LDA
#undef PG8_LDB
#undef PG8_MMA
#undef PG8_WAIT_V
#undef PG8_WAIT_L
#undef PG8_BAR
#undef PG8_SCHED
}
}

#ifndef MK_N_LAUNCHES
#define MK_N_LAUNCHES 1
#endif
#ifndef REPMASK
#define REPMASK 0
#endif
#define REP(k) _Pragma("unroll") for (int rep_ = 0; rep_ < (((REPMASK) >> (k)) & 1) + 1; ++rep_)
#ifndef SKIPMASK
#define SKIPMASK 0
#endif
constexpr int NPH = 8;
constexpr int NB = 8, SEQ = 4096, DM = 1024, NMETA = 16, DIN = 3072, DRG = 512, DFF = 2816;
constexpr int MROWS = NB * SEQ;
constexpr float EPS = 1e-6f;
constexpr size_t MiB = 1u << 20;
constexpr size_t WS_WIN = 0, WS_WO = 6 * MiB, WS_WGU = 8 * MiB, WS_WD = 19 * MiB, WS_WG = 25 * MiB;
constexpr size_t WS_RGA = 26 * MiB, WS_RGH = 26 * MiB + 512 * 1024, WS_HM = 27 * MiB, WS_BT = 27 * MiB + 64 * 1024, WS_SM = 28 * MiB;
constexpr size_t WS_SSQ1 = 30 * MiB, WS_SSQ2 = 32 * MiB, WS_SL = 34 * MiB;
constexpr size_t WS_BAR = 50 * MiB;
constexpr int MISC_OFF = 131072 + 320;
constexpr size_t WS_XN = 64 * MiB;
constexpr size_t WS_Y = 128 * MiB;
constexpr size_t WS_P = 192 * MiB;
constexpr size_t WS_END = 392 * MiB;
constexpr int LDS_BYTES = 147456;

#define LAS __attribute__((address_space(3)))
typedef unsigned short bf16;
typedef float f32x4 __attribute__((ext_vector_type(4)));
typedef short bf16x8 __attribute__((ext_vector_type(8)));
typedef unsigned v4u __attribute__((ext_vector_type(4)));
typedef unsigned v2u __attribute__((ext_vector_type(2)));
__device__ __forceinline__ float bf2f(unsigned short b) { return __uint_as_float(((unsigned)b) << 16); }
__device__ __forceinline__ unsigned f2bf(float f) { unsigned u = __float_as_uint(f); return (u + 0x7fffu + ((u >> 16) & 1u)) >> 16; }
__device__ __forceinline__ unsigned pk2(float lo, float hi) { return f2bf(lo) | (f2bf(hi) << 16); }
__device__ __forceinline__ float sigm(float x) { return __builtin_amdgcn_rcpf(1.0f + __expf(-x)); }
__device__ __forceinline__ float wave_sum(float v) {
#pragma unroll
    for (int o = 1; o < 64; o <<= 1) v += __shfl_xor(v, o);
    return v;
}
#define MFMA16(a, b, c) __builtin_amdgcn_mfma_f32_16x16x32_bf16((a), (b), (c), 0, 0, 0)

__device__ __forceinline__ void p0_transpose_item(const float* W, int K, int N, bf16* WT, LAS float* scr, int item, int lane, int mode, const float* ksc) {
    const int nblk = N / 32, kb = item / nblk, nb = item % nblk, k0 = 64 * kb, n0 = 32 * nb;
    int src0 = n0;
    if (mode == 1) { const int t = n0 >> 8, c = n0 & 255; src0 = (c < 128) ? (t * 128 + c) : (DFF + t * 128 + (c - 128)); }
#pragma unroll 8
    for (int i = 0; i < 32; ++i) { const int kk = 2 * i + (lane >> 5); float v = W[(size_t)(k0 + kk) * N + src0 + (lane & 31)]; if (mode == 1) v *= ksc[k0 + kk]; scr[kk * 33 + (lane & 31)] = v; }
    asm volatile("s_waitcnt lgkmcnt(0)" ::: "memory");
    const int c = lane & 7;
#pragma unroll
    for (int j = 0; j < 4; ++j) { const int n = (lane >> 3) + 8 * j; const LAS float* s = scr + (8 * c) * 33 + n;
        v4u o; o.x = pk2(s[0 * 33], s[1 * 33]); o.y = pk2(s[2 * 33], s[3 * 33]); o.z = pk2(s[4 * 33], s[5 * 33]); o.w = pk2(s[6 * 33], s[7 * 33]);
        *(v4u*)(WT + (size_t)(n0 + n) * K + k0 + 8 * c) = o; }
    asm volatile("s_waitcnt lgkmcnt(0)" ::: "memory");
}
__device__ __forceinline__ void rms_rows2_to_bf16(const float* xrow, const float* g, bf16* orow, int lane) {
    const f32x4* xr = (const f32x4*)xrow + lane; const f32x4* gr = (const f32x4*)g + lane;
    f32x4 v[2][4]; float s[2] = {0.f, 0.f};
#pragma unroll
    for (int r = 0; r < 2; ++r)
#pragma unroll
        for (int j = 0; j < 4; ++j) v[r][j] = xr[256 * r + 64 * j];
#pragma unroll
    for (int r = 0; r < 2; ++r)
#pragma unroll
        for (int j = 0; j < 4; ++j) s[r] += (v[r][j].x * v[r][j].x + v[r][j].y * v[r][j].y) + (v[r][j].z * v[r][j].z + v[r][j].w * v[r][j].w);
    const float rinv[2] = {rsqrtf(wave_sum(s[0]) * (1.f / DM) + EPS), rsqrtf(wave_sum(s[1]) * (1.f / DM) + EPS)};
    unsigned long long* o8 = (unsigned long long*)orow + lane;
#pragma unroll
    for (int j = 0; j < 4; ++j) { const f32x4 gg = gr[64 * j];
#pragma unroll
        for (int r = 0; r < 2; ++r)
            o8[256 * r + 64 * j] = (unsigned long long)pk2(v[r][j].x * rinv[r] * gg.x, v[r][j].y * rinv[r] * gg.y) | ((unsigned long long)pk2(v[r][j].z * rinv[r] * gg.z, v[r][j].w * rinv[r] * gg.w) << 32); }
}

constexpr int RG_WAVE_LDS = 10496;
__device__ __forceinline__ float bflo(unsigned u) { return __uint_as_float(u << 16); }
__device__ __forceinline__ float bfhi(unsigned u) { return __uint_as_float(u & 0xffff0000u); }
__device__ __forceinline__ unsigned cvtpk(float lo, float hi) { unsigned r; asm volatile("v_cvt_pk_bf16_f32 %0, %1, %2" : "=v"(r) : "v"(lo), "v"(hi)); return r; }
__device__ __forceinline__ void rg_scan(LAS unsigned char* lds, const bf16* P, const bf16* Wg, const float* conv_w, const float* conv_b, const float* b_r, const float* b_i, const float* lam,
                                        float* Aseg, float* Hseg, float* hmeta, bf16* HLOC, bf16* PAC, int b, int seg, bool is_meta, int wave, int lane) {
    const int c = wave * 64 + lane;
    LAS bf16* xcb = (LAS bf16*)(lds + wave * RG_WAVE_LDS);
    LAS float* pre_r = (LAS float*)(lds + wave * RG_WAVE_LDS + 2304);
    LAS float* pre_i = pre_r + 1024;
    const float cw0 = conv_w[c], cw1 = conv_w[DRG + c], cw2 = conv_w[2 * DRG + c], cw3 = conv_w[3 * DRG + c], cb = conv_b[c];
    const float br = b_r[c], bi = b_i[c];
    const float sp = 8.0f * log1pf(__expf(-lam[c]));
    bf16x8 bw[2][4][2];
#pragma unroll
    for (int g = 0; g < 2; ++g)
#pragma unroll
        for (int nt = 0; nt < 4; ++nt)
#pragma unroll
            for (int ks = 0; ks < 2; ++ks) bw[g][nt][ks] = *(const bf16x8*)(Wg + ((size_t)(g * 8 + wave) * 64 + nt * 16 + (lane & 15)) * 64 + ks * 32 + (lane >> 4) * 8);
    float h = 0.f, pa = 1.f, xm3 = 0.f, xm2 = 0.f, xm1 = 0.f;
    const int nsb = is_meta ? 1 : 8;
    const size_t row0 = is_meta ? (size_t)MROWS : (size_t)b * SEQ + (size_t)seg * 128;
    if (!is_meta) {
        const size_t r3 = (seg == 0) ? (size_t)MROWS + 13 : row0 - 3;
        xm3 = bf2f(P[r3 * DIN + c]); xm2 = bf2f(P[(r3 + 1) * DIN + c]); xm1 = bf2f(P[(r3 + 2) * DIN + c]);
    }
    for (int sb = 0; sb < nsb; ++sb) {
        const size_t rb = row0 + (size_t)sb * 16;
        float e[19], xc[16];
        e[0] = xm3; e[1] = xm2; e[2] = xm1;
#pragma unroll
        for (int i = 0; i < 16; ++i) e[3 + i] = bf2f(P[(rb + i) * DIN + c]);
        xm3 = e[16]; xm2 = e[17]; xm1 = e[18];
#pragma unroll
        for (int i = 0; i < 16; i += 2) { xc[i] = cb + cw0 * e[i] + cw1 * e[i + 1] + cw2 * e[i + 2] + cw3 * e[i + 3]; xc[i + 1] = cb + cw0 * e[i + 1] + cw1 * e[i + 2] + cw2 * e[i + 3] + cw3 * e[i + 4];
            const unsigned pk = cvtpk(xc[i], xc[i + 1]); xcb[i * 72 + lane] = (bf16)(pk & 0xffffu); xcb[(i + 1) * 72 + lane] = (bf16)(pk >> 16); }
        asm volatile("s_waitcnt lgkmcnt(0)" ::: "memory"); __builtin_amdgcn_wave_barrier();
        bf16x8 af[2];
#pragma unroll
        for (int ks = 0; ks < 2; ++ks) af[ks] = *(const LAS bf16x8*)(xcb + (lane & 15) * 72 + ks * 32 + (lane >> 4) * 8);
#pragma unroll
        for (int g = 0; g < 2; ++g)
#pragma unroll
            for (int nt = 0; nt < 4; ++nt) { f32x4 acc = {0.f, 0.f, 0.f, 0.f};
#pragma unroll
                for (int ks = 0; ks < 2; ++ks) acc = MFMA16(af[ks], bw[g][nt][ks], acc);
                LAS float* pre = g ? pre_i : pre_r;
#pragma unroll
                for (int j = 0; j < 4; ++j) pre[((lane >> 4) * 4 + j) * 64 + nt * 16 + (lane & 15)] = acc[j]; }
        asm volatile("s_waitcnt lgkmcnt(0)" ::: "memory"); __builtin_amdgcn_wave_barrier();
        float hv[16], pv[16];
#pragma unroll
        for (int i = 0; i < 16; ++i) {
            const float r = sigm(pre_r[i * 64 + lane] + br), ig = sigm(pre_i[i * 64 + lane] + bi);
            const float la = -sp * r, a = __expf(la), x2 = 2.0f * la;
            const float poly = -x2 * (1.0f + x2 * 0.5f * (1.0f + x2 * (1.0f / 3.0f) * (1.0f + x2 * 0.25f * (1.0f + x2 * 0.2f * (1.0f + x2 * (1.0f / 6.0f))))));
            const float om = (x2 > -0.25f) ? poly : (1.0f - a * a);
            h = a * h + __builtin_amdgcn_sqrtf(om) * (ig * xc[i]); pa *= a; hv[i] = h; pv[i] = pa;
        }
        asm volatile("s_waitcnt lgkmcnt(0)" ::: "memory"); __builtin_amdgcn_wave_barrier();
        if (!is_meta) {
#pragma unroll
            for (int i = 0; i < 16; i += 2) { const unsigned hp = cvtpk(hv[i], hv[i + 1]), pp = cvtpk(pv[i], pv[i + 1]);
                HLOC[(rb + i) * DRG + c] = (bf16)(hp & 0xffffu); HLOC[(rb + i + 1) * DRG + c] = (bf16)(hp >> 16);
                PAC[(rb + i) * DRG + c] = (bf16)(pp & 0xffffu); PAC[(rb + i + 1) * DRG + c] = (bf16)(pp >> 16); }
        }
    }
    if (is_meta) hmeta[c] = h; else { Aseg[(size_t)(b * 32 + seg) * DRG + c] = pa; Hseg[(size_t)(b * 32 + seg) * DRG + c] = h; }
}
__device__ __forceinline__ void rg_final(LAS unsigned char* lds, const bf16* P, const bf16* HLOC, const bf16* PAC, const float* Aseg, const float* Hseg, const float* hmeta, const float* gnorm, bf16* Y,
                                         int b, int seg, int tid, int wave, int lane) {
    LAS float* hin = (LAS float*)lds;
    { float h = hmeta[tid]; const float* ap = Aseg + (size_t)b * 32 * DRG + tid; const float* hp = Hseg + (size_t)b * 32 * DRG + tid;
#pragma unroll 8
      for (int j = 0; j < seg; ++j) h = ap[(size_t)j * DRG] * h + hp[(size_t)j * DRG];
      hin[tid] = h; }
    __syncthreads();
    const f32x4 h0 = *(const LAS f32x4*)(hin + 8 * lane), h1 = *(const LAS f32x4*)(hin + 8 * lane + 4);
    const f32x4 g0 = *(const f32x4*)(gnorm + 8 * lane), g1 = *(const f32x4*)(gnorm + 8 * lane + 4);
    const float hi8[8] = {h0.x, h0.y, h0.z, h0.w, h1.x, h1.y, h1.z, h1.w}, gn8[8] = {g0.x, g0.y, g0.z, g0.w, g1.x, g1.y, g1.z, g1.w};
#pragma unroll 4
    for (int i = 0; i < 16; ++i) { const size_t row = (size_t)b * SEQ + (size_t)seg * 128 + wave * 16 + i;
        const v4u hl = *(const v4u*)(HLOC + row * DRG + 8 * lane), pc = *(const v4u*)(PAC + row * DRG + 8 * lane), gv = *(const v4u*)(P + row * DIN + DRG + 8 * lane);
        float y[8]; float s = 0.f;
#pragma unroll
        for (int q = 0; q < 4; ++q) { const float hA = bflo(hl[q]) + bflo(pc[q]) * hi8[2 * q], hB = bfhi(hl[q]) + bfhi(pc[q]) * hi8[2 * q + 1]; const float gA = bflo(gv[q]), gB = bfhi(gv[q]);
            y[2 * q] = gA * sigm(1.5957691216f * (gA + 0.044715f * gA * gA * gA)) * hA; y[2 * q + 1] = gB * sigm(1.5957691216f * (gB + 0.044715f * gB * gB * gB)) * hB;
            s += y[2 * q] * y[2 * q] + y[2 * q + 1] * y[2 * q + 1]; }
        const float rinv = rsqrtf(wave_sum(s) * (1.0f / DRG) + EPS);
        v4u o;
#pragma unroll
        for (int q = 0; q < 4; ++q) o[q] = cvtpk(y[2 * q] * rinv * gn8[2 * q], y[2 * q + 1] * rinv * gn8[2 * q + 1]);
        *(v4u*)(Y + row * DM + 8 * lane) = o; }
}

constexpr int HG_QT = 0, HG_KH = 17408, HG_KHT = 34816, HG_VT = 53248, HG_ST = 71680, HG_AM = 106496, HG_GS = 115712, HG_EB = 117760, HG_SQ = 118272;
template <bool FINAL>
__device__ __forceinline__ void hg_run(LAS unsigned char* lds, const bf16* P, const float* Lb, const float* gnorm, float* Sloc, float* Btot, float* Smeta, bf16* Y,
                                       int b, int h, int sc, bool is_meta, int tid, int wave, int lane) {
    LAS bf16* Qt = (LAS bf16*)(lds + HG_QT); LAS bf16* Kh = (LAS bf16*)(lds + HG_KH); LAS bf16* KhT = (LAS bf16*)(lds + HG_KHT); LAS bf16* VT = (LAS bf16*)(lds + HG_VT);
    LAS bf16* St = (LAS bf16*)(lds + HG_ST); LAS bf16* Am = (LAS bf16*)(lds + HG_AM); LAS float* gsum = (LAS float*)(lds + HG_GS); LAS float* eb = (LAS float*)(lds + HG_EB); LAS float* ssqp = (LAS float*)(lds + HG_SQ);
    const int g = tid >> 7, k = tid & 127, lr = lane & 15, lq = lane >> 4;
    const float lb = 1.0f / (1.0f + __expf(Lb[DRG + h * 128 + k] - Lb[h * 128 + k]));
    const int item = (b * 4 + h) * 8 + sc;
    f32x4 S[8];
#pragma unroll
    for (int tv = 0; tv < 8; ++tv) S[tv] = (f32x4){0.f, 0.f, 0.f, 0.f};
    if (FINAL) {
#pragma unroll
        for (int j = 0; j < 4; ++j) { const int kr = 16 * wave + 4 * lq + j;
#pragma unroll
            for (int tv = 0; tv < 8; ++tv) S[tv][j] = Smeta[(size_t)(h * 128 + kr) * 128 + 16 * tv + lr]; }
        for (int jj = 0; jj < sc; ++jj) { const int it = (b * 4 + h) * 8 + jj;
#pragma unroll
            for (int j = 0; j < 4; ++j) { const int kr = 16 * wave + 4 * lq + j; const float d = __expf(Btot[(size_t)it * 128 + kr]);
#pragma unroll
                for (int tv = 0; tv < 8; ++tv) S[tv][j] = d * S[tv][j] + Sloc[((size_t)it * 128 + kr) * 128 + 16 * tv + lr]; } }
#pragma unroll
        for (int tv = 0; tv < 8; ++tv) { v2u w; w.x = pk2(S[tv][0], S[tv][1]); w.y = pk2(S[tv][2], S[tv][3]); *(LAS v2u*)(St + (16 * tv + lr) * 136 + 16 * wave + 4 * lq) = w; }
    }
    float btot = 0.f;
    const int nch = is_meta ? 1 : 8, nvalid = is_meta ? NMETA : 64;
    for (int ch = 0; ch < nch; ++ch) {
        const size_t rowbase = is_meta ? (size_t)MROWS : (size_t)b * SEQ + (size_t)sc * 512 + (size_t)ch * 64;
        float lfc[16], kk[16], qv[16]; unsigned short vb[16]; float cum = 0.f;
#pragma unroll
        for (int i = 0; i < 16; ++i) { const int s = 16 * g + i; const bool valid = s < nvalid; const size_t row = rowbase + (valid ? s : 0); const bf16* pr = P + row * DIN + h * 128 + k;
            const float hf = bf2f(pr[1536]); const float f = lb + (1.0f - lb) * sigm(hf);
            const float lf = valid ? __logf(f) : 0.f; kk[i] = valid ? (1.0f - f) : 0.f; cum += lf; lfc[i] = cum;
            vb[i] = valid ? pr[2048] : (unsigned short)0;
            if (FINAL) { const float hq = bf2f(pr[1024]); qv[i] = hq * sigm(hq); } }
        gsum[g * 128 + k] = cum;
        __syncthreads();
        float pre = 0.f, tot = 0.f;
#pragma unroll
        for (int gg = 0; gg < 4; ++gg) { const float v = gsum[gg * 128 + k]; tot += v; pre += (gg < g) ? v : 0.f; }
        unsigned kp[8], vp[8];
#pragma unroll
        for (int i = 0; i < 16; i += 2) { const float b0 = pre + lfc[i], b1 = pre + lfc[i + 1];
            const unsigned k0 = f2bf(kk[i] * __expf(-b0)), k1 = f2bf(kk[i + 1] * __expf(-b1));
            kp[i >> 1] = k0 | (k1 << 16); vp[i >> 1] = (unsigned)vb[i] | ((unsigned)vb[i + 1] << 16);
            if (FINAL) { Kh[(16 * g + i) * 136 + k] = (bf16)k0; Kh[(16 * g + i + 1) * 136 + k] = (bf16)k1;
                Qt[(16 * g + i) * 136 + k] = (bf16)f2bf(qv[i] * __expf(b0)); Qt[(16 * g + i + 1) * 136 + k] = (bf16)f2bf(qv[i + 1] * __expf(b1)); } }
        *(LAS v4u*)(KhT + k * 72 + 16 * g) = (v4u){kp[0], kp[1], kp[2], kp[3]}; *(LAS v4u*)(KhT + k * 72 + 16 * g + 8) = (v4u){kp[4], kp[5], kp[6], kp[7]};
        *(LAS v4u*)(VT + k * 72 + 16 * g) = (v4u){vp[0], vp[1], vp[2], vp[3]}; *(LAS v4u*)(VT + k * 72 + 16 * g + 8) = (v4u){vp[4], vp[5], vp[6], vp[7]};
        if (g == 0) eb[k] = __expf(tot);
        btot += tot;
        __syncthreads();
        if (FINAL) {
            { const int tt = wave >> 1;
#pragma unroll
              for (int q = 0; q < 2; ++q) { const int ts = 2 * (wave & 1) + q; f32x4 acc = {0.f, 0.f, 0.f, 0.f};
#pragma unroll
                for (int ks = 0; ks < 4; ++ks) { const bf16x8 a = *(const LAS bf16x8*)(Qt + (16 * tt + lr) * 136 + ks * 32 + lq * 8); const bf16x8 bb = *(const LAS bf16x8*)(Kh + (16 * ts + lr) * 136 + ks * 32 + lq * 8); acc = MFMA16(a, bb, acc); }
#pragma unroll
                for (int j = 0; j < 4; ++j) { const int t = 16 * tt + 4 * lq + j, s = 16 * ts + lr; Am[t * 72 + s] = (bf16)f2bf((s <= t) ? acc[j] : 0.f); } } }
            __syncthreads();
            const int tt = wave & 3, vh = wave >> 2;
            f32x4 o[4];
#pragma unroll
            for (int q = 0; q < 4; ++q) o[q] = (f32x4){0.f, 0.f, 0.f, 0.f};
#pragma unroll
            for (int ks = 0; ks < 4; ++ks) { const bf16x8 a = *(const LAS bf16x8*)(Qt + (16 * tt + lr) * 136 + ks * 32 + lq * 8);
#pragma unroll
                for (int q = 0; q < 4; ++q) { const bf16x8 bb = *(const LAS bf16x8*)(St + (16 * (4 * vh + q) + lr) * 136 + ks * 32 + lq * 8); o[q] = MFMA16(a, bb, o[q]); } }
#pragma unroll
            for (int ks = 0; ks < 2; ++ks) { const bf16x8 a = *(const LAS bf16x8*)(Am + (16 * tt + lr) * 72 + ks * 32 + lq * 8);
#pragma unroll
                for (int q = 0; q < 4; ++q) { const bf16x8 bb = *(const LAS bf16x8*)(VT + (16 * (4 * vh + q) + lr) * 72 + ks * 32 + lq * 8); o[q] = MFMA16(a, bb, o[q]); } }
#pragma unroll
            for (int j = 0; j < 4; ++j) { float p = (o[0][j] * o[0][j] + o[1][j] * o[1][j]) + (o[2][j] * o[2][j] + o[3][j] * o[3][j]);
                p += __shfl_xor(p, 1); p += __shfl_xor(p, 2); p += __shfl_xor(p, 4); p += __shfl_xor(p, 8);
                if (lr == 0) ssqp[vh * 64 + 16 * tt + 4 * lq + j] = p; }
            __syncthreads();
#pragma unroll
            for (int j = 0; j < 4; ++j) { const int t = 16 * tt + 4 * lq + j; const float rinv = rsqrtf((ssqp[t] + ssqp[64 + t]) * (1.0f / 128.0f) + EPS); const size_t row = rowbase + t;
#pragma unroll
                for (int q = 0; q < 4; ++q) { const int v = 16 * (4 * vh + q) + lr; const float hgv = bf2f(P[row * DIN + 2560 + h * 128 + v]);
                    Y[row * DM + DRG + h * 128 + v] = (bf16)f2bf(o[q][j] * rinv * gnorm[v] * (hgv * sigm(hgv))); } }
        }
#pragma unroll
        for (int ks = 0; ks < 2; ++ks) { const bf16x8 a = *(const LAS bf16x8*)(KhT + (16 * wave + lr) * 72 + ks * 32 + lq * 8);
#pragma unroll
            for (int tv = 0; tv < 8; ++tv) { const bf16x8 bb = *(const LAS bf16x8*)(VT + (16 * tv + lr) * 72 + ks * 32 + lq * 8); S[tv] = MFMA16(a, bb, S[tv]); } }
#pragma unroll
        for (int j = 0; j < 4; ++j) { const float e = eb[16 * wave + 4 * lq + j];
#pragma unroll
            for (int tv = 0; tv < 8; ++tv) S[tv][j] *= e; }
        if (FINAL) {
#pragma unroll
            for (int tv = 0; tv < 8; ++tv) { v2u w; w.x = pk2(S[tv][0], S[tv][1]); w.y = pk2(S[tv][2], S[tv][3]); *(LAS v2u*)(St + (16 * tv + lr) * 136 + 16 * wave + 4 * lq) = w; }
        }
    }
    if (!FINAL) {
        float* dst = is_meta ? (Smeta + (size_t)h * 128 * 128) : (Sloc + (size_t)item * 128 * 128);
#pragma unroll
        for (int j = 0; j < 4; ++j) { const int kr = 16 * wave + 4 * lq + j;
#pragma unroll
            for (int tv = 0; tv < 8; ++tv) dst[(size_t)kr * 128 + 16 * tv + lr] = S[tv][j]; }
        if (!is_meta && g == 0) Btot[(size_t)item * 128 + k] = btot;
    }
}

#define XB_TMO      128
#define XB_XCNT(j)  (256  + 64 * (j))
#define XB_XSUB(j)  (1280 + 64 * (j))
#define XB_XGEN(j)  (2304 + 64 * (j))
#define XB_TOP      3328
#define XB_TOPGEN   3392
#define XCD_BAR_WORDS 3456
#define XB_SPIN_CAP (1u << 18)

__device__ __forceinline__ unsigned xb_ld(unsigned* p)              { return __hip_atomic_load(p, __ATOMIC_RELAXED, __HIP_MEMORY_SCOPE_AGENT); }
__device__ __forceinline__ unsigned xb_add(unsigned* p, unsigned v) { return __hip_atomic_fetch_add(p, v, __ATOMIC_RELAXED, __HIP_MEMORY_SCOPE_AGENT); }
__device__ __forceinline__ unsigned xb_xcc_id() { return (unsigned)__builtin_amdgcn_s_getreg((3 << 11) | 20) & 0xFu; }
#define XB_SPIN(cond, bar) do { unsigned _sp = 0; while (cond) { __builtin_amdgcn_s_sleep(1); \
    if ((++_sp & 255u) == 0u) { if (xb_ld(&(bar)[XB_TMO])) break; if (_sp > XB_SPIN_CAP) { atomicAdd(&(bar)[XB_TMO], 1u); break; } } } } while (0)

struct XcdBarrier {
    unsigned* bar; unsigned x;
    volatile LAS unsigned* st;
};

__device__ __forceinline__ XcdBarrier xcd_barrier_post(unsigned* bar, volatile LAS unsigned* st) {
    XcdBarrier b; b.bar = bar; b.x = xb_xcc_id(); b.st = st;
    if (threadIdx.x == 0) (void)xb_add(&bar[XB_XCNT(b.x)], 1u);
    return b;
}
__device__ __forceinline__ void xcd_barrier_complete(unsigned* bar, unsigned x, unsigned& nloc, unsigned& nx) {
    const unsigned G = gridDim.x * gridDim.y * gridDim.z;
    unsigned sum, cnt, mine, sp = 0u;
    for (;;) {
        sum = 0u; cnt = 0u; mine = 0u;
#pragma unroll
        for (unsigned j = 0; j < 16; ++j) { const unsigned c = xb_ld(&bar[XB_XCNT(j)]); sum += c; cnt += (c > 0u) ? 1u : 0u; mine = (j == x) ? c : mine; }
        if (sum == G) break;
        __builtin_amdgcn_s_sleep(1);
        if ((++sp & 255u) == 0u) { if (xb_ld(&bar[XB_TMO])) break; if (sp > XB_SPIN_CAP) { atomicAdd(&bar[XB_TMO], 1u); break; } }
    }
    nloc = mine > 0u ? mine : 1u; nx = cnt > 0u ? cnt : 1u;
}

__device__ __forceinline__ void xcd_barrier(const XcdBarrier& b) {
    asm volatile("s_waitcnt vmcnt(0)" ::: "memory");
    __syncthreads();
    if (threadIdx.x == 0) {
        unsigned* bar = b.bar;
        __builtin_amdgcn_s_waitcnt(0);
        unsigned nloc = b.st[0], nx = b.st[1];
        if (nloc == 0u) { xcd_barrier_complete(bar, b.x, nloc, nx); b.st[0] = nloc; b.st[1] = nx; }
        const unsigned old = xb_add(&bar[XB_XSUB(b.x)], 1u);
        const unsigned gen = old / nloc;
        if (old + 1u == (gen + 1u) * nloc) {
            __builtin_amdgcn_fence(__ATOMIC_RELEASE, "agent");
            asm volatile("s_waitcnt vmcnt(0)" ::: "memory");
            const unsigned og = xb_add(&bar[XB_TOP], 1u);
            const unsigned tg = og / nx;
            if (og + 1u == (tg + 1u) * nx) xb_add(&bar[XB_TOPGEN], 1u);
            else XB_SPIN(xb_ld(&bar[XB_TOPGEN]) == tg, bar);
            __builtin_amdgcn_fence(__ATOMIC_ACQUIRE, "agent");
            xb_add(&bar[XB_XGEN(b.x)], 1u);
            asm volatile("s_waitcnt vmcnt(0)" ::: "memory");
        } else {
            XB_SPIN(xb_ld(&bar[XB_XGEN(b.x)]) == gen, bar);
            __builtin_amdgcn_fence(__ATOMIC_ACQUIRE, "agent");
            asm volatile("s_waitcnt vmcnt(0)" ::: "memory");
        }
    }
    __syncthreads();
}

struct Args { const float* in[19]; float* out; unsigned char* ws; int ph_lo, ph_hi; };
__global__ void __launch_bounds__(512, 2) fwd_megakernel(Args args) {
    extern __shared__ __attribute__((aligned(16))) unsigned char lds_raw[];
    LAS unsigned char* lds = (LAS unsigned char*)lds_raw;
    cg::grid_group grid = cg::this_grid();
    const int tid = threadIdx.x, lane = tid & 63, wave = __builtin_amdgcn_readfirstlane(tid >> 6);
    const int G = gridDim.x, bx = blockIdx.x;
    unsigned char* ws = args.ws;
    const float* x = args.in[0]; const float* meta = args.in[1]; const float* mix_g = args.in[2]; const float* w_in = args.in[3];
    const float* conv_w = args.in[4]; const float* conv_b = args.in[5]; const float* w_rg = args.in[6]; const float* b_rg = args.in[7];
    const float* w_ig = args.in[8]; const float* b_ig = args.in[9]; const float* lam = args.in[10]; const float* rg_g = args.in[11];
    const float* hg_lb = args.in[12]; const float* hg_g = args.in[13]; const float* w_out = args.in[14]; const float* ffn_g = args.in[15];
    const float* w_gu = args.in[16]; const float* w_down = args.in[17]; const float* fin_g = args.in[18];
    bf16* Win_t = (bf16*)(ws + WS_WIN); bf16* Wo_t = (bf16*)(ws + WS_WO); bf16* Wgu_t = (bf16*)(ws + WS_WGU); bf16* Wd_t = (bf16*)(ws + WS_WD); bf16* Wg_t = (bf16*)(ws + WS_WG);
    float* Aseg = (float*)(ws + WS_RGA); float* Hseg = (float*)(ws + WS_RGH); float* hmeta = (float*)(ws + WS_HM); float* Btot = (float*)(ws + WS_BT); float* Smeta = (float*)(ws + WS_SM);
    float* SSQ1 = (float*)(ws + WS_SSQ1); float* SSQ2 = (float*)(ws + WS_SSQ2); float* Sloc = (float*)(ws + WS_SL);
    bf16* XN = (bf16*)(ws + WS_XN); bf16* H1B = (bf16*)(ws + WS_XN); bf16* HLOC = (bf16*)(ws + WS_XN); bf16* PAC = (bf16*)(ws + WS_XN + 32 * MiB); bf16* Y = (bf16*)(ws + WS_Y); bf16* P = (bf16*)(ws + WS_P); bf16* ACT = (bf16*)(ws + WS_P);
    float* out = args.out;
    const int lo = args.ph_lo, hi = args.ph_hi;
    volatile LAS unsigned* misc = (volatile LAS unsigned*)(lds + MISC_OFF);
    if (tid < 2) misc[tid] = 0u;
    __syncthreads();
    (void)xcd_barrier_post((unsigned*)(ws + WS_BAR), misc);
    if (hi > 1000) grid.sync();
#define IN(k) (lo <= (k) && (k) < hi)
#define GBAR() do { XcdBarrier b_; b_.bar = (unsigned*)(args.ws + WS_BAR); b_.x = xb_xcc_id(); b_.st = (volatile LAS unsigned*)(lds + MISC_OFF); xcd_barrier(b_); } while (0)
#define SEAM(k) do { if (IN(k) && IN((k) + 1)) GBAR(); } while (0)

    REP(0) if (IN(0) && !(SKIPMASK & 1)) { if (rep_) GBAR();
        const bool split = G > 48;
        const int gw = split ? (bx - 24) * 8 + wave : bx * 8 + wave, NGW = split ? (G - 24) * 8 : G * 8;
        if (bx < 24) {
            LAS float* um = (LAS float*)lds;
            LAS float* red = (LAS float*)(lds + 65536);
#pragma unroll
            for (int r = 0; r < 2; ++r) { const int m = wave * 2 + r; const f32x4* xr = (const f32x4*)(meta + (size_t)m * DM) + lane; const f32x4* gr = (const f32x4*)mix_g + lane;
                f32x4 v[4]; float s = 0.f;
#pragma unroll
                for (int j = 0; j < 4; ++j) { v[j] = xr[64 * j]; s += (v[j].x * v[j].x + v[j].y * v[j].y) + (v[j].z * v[j].z + v[j].w * v[j].w); }
                const float rinv = rsqrtf(wave_sum(s) * (1.f / DM) + EPS);
#pragma unroll
                for (int j = 0; j < 4; ++j) { const f32x4 gg = gr[64 * j]; const int k0 = 256 * j + 4 * lane;
                    um[(k0 + 0) * 16 + m] = v[j].x * rinv * gg.x; um[(k0 + 1) * 16 + m] = v[j].y * rinv * gg.y; um[(k0 + 2) * 16 + m] = v[j].z * rinv * gg.z; um[(k0 + 3) * 16 + m] = v[j].w * rinv * gg.w; } }
            __syncthreads();
            const int kg = tid >> 7, nl = tid & 127, n = bx * 128 + nl;
            float acc[16];
#pragma unroll
            for (int m = 0; m < 16; ++m) acc[m] = 0.f;
#pragma unroll 8
            for (int kk = kg * 256; kk < kg * 256 + 256; ++kk) { const float w = w_in[(size_t)kk * DIN + n]; const LAS f32x4* u4 = (const LAS f32x4*)(um + kk * 16);
#pragma unroll
                for (int q = 0; q < 4; ++q) { const f32x4 uv = u4[q]; acc[4 * q + 0] += w * uv.x; acc[4 * q + 1] += w * uv.y; acc[4 * q + 2] += w * uv.z; acc[4 * q + 3] += w * uv.w; } }
#pragma unroll
            for (int m = 0; m < 16; ++m) red[(kg * 16 + m) * 128 + nl] = acc[m];
            __syncthreads();
            for (int o = tid; o < 2048; o += 512) { const int m = o >> 7, n2 = o & 127;
                const float s = (red[(0 * 16 + m) * 128 + n2] + red[(1 * 16 + m) * 128 + n2]) + (red[(2 * 16 + m) * 128 + n2] + red[(3 * 16 + m) * 128 + n2]);
                P[(size_t)(MROWS + m) * DIN + bx * 128 + n2] = (bf16)f2bf(s); }
            __syncthreads();
        }
        if (!split || bx >= 24) {
        LAS float* scr = (LAS float*)(lds + wave * 16384);
        constexpr int I_IN = (DM / 64) * (DIN / 32), I_O = (DM / 64) * (DM / 32), I_GU = (DM / 64) * (2 * DFF / 32), I_D = (DFF / 64) * (DM / 32);
        constexpr int NITEMS = I_IN + I_O + I_GU + I_D;
        for (int it = gw; it < NITEMS; it += NGW) {
            int r = it;
            if (r < I_IN) { p0_transpose_item(w_in, DM, DIN, Win_t, scr, r, lane, 0, nullptr); continue; } r -= I_IN;
            if (r < I_O) { p0_transpose_item(w_out, DM, DM, Wo_t, scr, r, lane, 0, nullptr); continue; } r -= I_O;
            if (r < I_GU) { p0_transpose_item(w_gu, DM, 2 * DFF, Wgu_t, scr, r, lane, 1, ffn_g); continue; } r -= I_GU;
            p0_transpose_item(w_down, DFF, DM, Wd_t, scr, r, lane, 0, nullptr);
        }
        for (int i = gw * 64 + lane; i < 2 * 8 * 64 * 64; i += NGW * 64) {
            const int gt = i >> 15, hh = (i >> 12) & 7, j = (i >> 6) & 63, ii = i & 63;
            Wg_t[i] = (bf16)f2bf((gt ? w_ig : w_rg)[hh * 4096 + ii * 64 + j]); }
        for (int m = 2 * gw; m < MROWS; m += 2 * NGW) rms_rows2_to_bf16(x + (size_t)m * DM, mix_g, XN + (size_t)m * DM, lane);
        }
    }
    SEAM(0);
#ifdef EXTRA_SYNCS
    for (int q_ = 0; q_ < EXTRA_SYNCS; ++q_) GBAR();
#endif
    REP(1) if (IN(1) && !(SKIPMASK & 2)) { if (rep_) GBAR();
        pg8::Gemm g{XN, Win_t, MROWS, DIN, DM}; pg8::StaticOrder S; S.init(MROWS, DIN, G, bx);
        pg8::EpiP E{P, DIN};
        pg8::gemm_phase<pg8::EpiP, pg8::StaticOrder, true, true>(lds, g, S, E);
    }
    SEAM(1);
    REP(2) if (IN(2) && !(SKIPMASK & 4)) { if (rep_) GBAR();
        for (int it = bx; it < 256; it += G) {
            int wv = wave, ln = lane, td = tid; asm volatile("" : "+s"(wv), "+v"(ln), "+v"(td));
#ifndef NO_RG
            rg_scan(lds, P, Wg_t, conv_w, conv_b, b_rg, b_ig, lam, Aseg, Hseg, hmeta, HLOC, PAC, it >> 5, it & 31, false, wv, ln);
            if (it == 255) rg_scan(lds, P, Wg_t, conv_w, conv_b, b_rg, b_ig, lam, Aseg, Hseg, hmeta, HLOC, PAC, 0, 0, true, wv, ln);
#endif
            __syncthreads();
#ifndef NO_HG
            hg_run<false>(lds, P, hg_lb, hg_g, Sloc, Btot, Smeta, Y, it >> 5, (it >> 3) & 3, it & 7, false, td, wv, ln);
            __syncthreads();
            if (it < 4) { hg_run<false>(lds, P, hg_lb, hg_g, Sloc, Btot, Smeta, Y, 0, it, 0, true, td, wv, ln); __syncthreads(); }
#endif
        }
    }
    SEAM(2);
    REP(3) if (IN(3) && !(SKIPMASK & 8)) { if (rep_) GBAR();
        for (int it = bx; it < 256; it += G) {
            int wv = wave, ln = lane, td = tid; asm volatile("" : "+s"(wv), "+v"(ln), "+v"(td));
#ifndef NO_RG
            rg_final(lds, P, HLOC, PAC, Aseg, Hseg, hmeta, rg_g, Y, it >> 5, it & 31, td, wv, ln);
            __syncthreads();
#endif
#ifndef NO_HG
            hg_run<true>(lds, P, hg_lb, hg_g, Sloc, Btot, Smeta, Y, it >> 5, (it >> 3) & 3, it & 7, false, td, wv, ln);
            __syncthreads();
#endif
        }
    }
    SEAM(3);
    REP(4) if (IN(4) && !(SKIPMASK & 16)) { if (rep_) GBAR();
        pg8::Gemm g{Y, Wo_t, MROWS, DM, DM}; pg8::StaticOrder S; S.init(MROWS, DM, G, bx);
        pg8::EpiOut E{x, H1B, SSQ1};
        pg8::gemm_phase<pg8::EpiOut, pg8::StaticOrder, true, true>(lds, g, S, E);
    }
    SEAM(4);
    REP(5) if (IN(5) && !(SKIPMASK & 32)) { if (rep_) GBAR();
        pg8::Gemm g{H1B, Wgu_t, MROWS, 2 * DFF, DM}; pg8::StaticOrder S; S.init(MROWS, 2 * DFF, G, bx);
        pg8::EpiGU E{SSQ1, ACT};
        pg8::gemm_phase<pg8::EpiGU, pg8::StaticOrder, true, true>(lds, g, S, E);
    }
    SEAM(5);
    REP(6) if (IN(6) && !(SKIPMASK & 64)) { if (rep_) GBAR();
        pg8::Gemm g{ACT, Wd_t, MROWS, DM, DFF}; pg8::StaticOrder S; S.init(MROWS, DM, G, bx);
        pg8::EpiDown E{H1B, SSQ2};
        pg8::gemm_phase<pg8::EpiDown, pg8::StaticOrder, true, true>(lds, g, S, E);
    }
    SEAM(6);
    REP(7) if (IN(7) && !(SKIPMASK & 128)) { if (rep_) GBAR();
        const int gw = bx * 8 + wave, NGW = G * 8;
        for (int m = gw; m < MROWS; m += NGW) {
            const float sv = (lane < 16) ? SSQ2[(size_t)m * 16 + lane] : 0.f;
            const float rinv = rsqrtf(wave_sum(sv) * (1.f / DM) + EPS);
            const float* gp = fin_g;
#pragma unroll
            for (int j = 0; j < 2; ++j) { const int c0 = (64 * j + lane) * 8; const v4u hv = *(const v4u*)(H1B + (size_t)m * DM + c0); const f32x4 ga = *(const f32x4*)(gp + c0), gb = *(const f32x4*)(gp + c0 + 4);
                f32x4 oa = {bflo(hv.x) * rinv * ga.x, bfhi(hv.x) * rinv * ga.y, bflo(hv.y) * rinv * ga.z, bfhi(hv.y) * rinv * ga.w};
                f32x4 ob = {bflo(hv.z) * rinv * gb.x, bfhi(hv.z) * rinv * gb.y, bflo(hv.w) * rinv * gb.z, bfhi(hv.w) * rinv * gb.w};
                *(f32x4*)(out + (size_t)m * DM + c0) = oa; *(f32x4*)(out + (size_t)m * DM + c0 + 4) = ob; }
        }
    }
#undef IN
#undef SEAM
}

extern "C" void kernel_launch(void* const* d_in, const int* in_sizes, int n_in, void* d_out, int out_size, void* d_ws, size_t ws_size, hipStream_t stream) {
    static int grid = 0;
    if (grid == 0) {
        if (n_in != 19 || in_sizes[0] != MROWS * DM || out_size != MROWS * DM || ws_size < WS_END) { fprintf(stderr, "kernel_launch: unexpected shapes (n_in %d, in0 %d, out %d, ws %zu)\n", n_in, n_in > 0 ? in_sizes[0] : -1, out_size, ws_size); grid = -1; return; }
        int dev = 0, cus = 0, per_cu = 0;
        hipGetDevice(&dev); hipDeviceGetAttribute(&cus, hipDeviceAttributeMultiprocessorCount, dev);
        if (hipFuncSetAttribute((const void*)fwd_megakernel, hipFuncAttributeMaxDynamicSharedMemorySize, LDS_BYTES) != hipSuccess) { fprintf(stderr, "kernel_launch: hipFuncSetAttribute failed\n"); grid = -1; return; }
        if (hipOccupancyMaxActiveBlocksPerMultiprocessor(&per_cu, (const void*)fwd_megakernel, 512, LDS_BYTES) != hipSuccess || per_cu < 1) { fprintf(stderr, "kernel_launch: occupancy query gave %d\n", per_cu); per_cu = 1; }
        (void)hipGetLastError();
        grid = cus * per_cu;
        fprintf(stderr, "kernel_launch: grid %d (cus %d x %d)\n", grid, cus, per_cu);
    }
    if (grid < 0) return;
    Args a{};
    for (int i = 0; i < 19; ++i) a.in[i] = (const float*)d_in[i];
    a.out = (float*)d_out; a.ws = (unsigned char*)d_ws;
#if MK_N_LAUNCHES == 1
    if (hipMemsetAsync((char*)d_ws + WS_BAR, 0, XCD_BAR_WORDS * 4, stream) != hipSuccess) { fprintf(stderr, "kernel_launch: memset failed\n"); return; }
    a.ph_lo = 0; a.ph_hi = NPH;
    void* kargs[] = {&a};
    hipError_t e = hipLaunchCooperativeKernel((const void*)fwd_megakernel, dim3(grid), dim3(512), kargs, LDS_BYTES, stream);
    if (e != hipSuccess) fprintf(stderr, "kernel_launch: cooperative launch failed: %s (grid %d)\n", hipGetErrorString(e), grid);
#else
    for (int p = 0; p < NPH; ++p) { a.ph_lo = p; a.ph_hi = p + 1; hipLaunchKernelGGL(fwd_megakernel, dim3(grid), dim3(512), LDS_BYTES, stream, a); }
#endif
}
```

```cpp
#include <hip/hip_runtime.h>
#include <hip/hip_cooperative_groups.h>
#include <cstdio>
#include <cstdint>
namespace cg = cooperative_groups;
namespace pg8 {
#define PG8_LAS __attribute__((address_space(3)))
typedef unsigned short bf16_t;
typedef short bf16x8 __attribute__((ext_vector_type(8)));
typedef float f32x4 __attribute__((ext_vector_type(4)));
typedef unsigned u32x4 __attribute__((ext_vector_type(4)));
constexpr int BM = 256, BK = 64, HALF = 128, HTB = HALF * BK * 2  , STAGE_BYTES = 8 * HTB, NXCD = 8, WGM = 8;

__host__ __device__ __forceinline__ int lds_byte(int r, int c) { const int st = (r >> 4) * 2 + (c >> 5), rr = r & 15, cc = c & 31, ob = rr * 64 + cc * 2; return st * 1024 + (ob ^ (((ob >> 9) & 1) << 5)); }
__host__ __device__ __forceinline__ void stage_rc(int b, int& R, int& C) { const int st = b / 1024, sb = b % 1024, swz = sb ^ (((sb >> 9) & 1) << 5); R = (st >> 1) * 16 + swz / 64; C = (st & 1) * 32 + (swz % 64) / 2; }
__host__ __device__ __forceinline__ int perm32(int rho) { const int n = rho >> 4, i = rho & 15; return 8 * (i >> 2) + 4 * n + (i & 3); }

struct Unit { int pm, pn; };
struct Gemm { const bf16_t* A; const bf16_t* Bt; int M, N, K; };

struct StaticOrder {
    int nM, nN, nwg, G, c;
    __host__ __device__ void init(int M, int N, int G_, int c_) { nM = M / BM; nN = N / BM; nwg = nM * nN; G = G_; c = c_; }
    __host__ __device__ bool next(int i, Unit& u) const {
        const long L = (long)i * G + c; if (L >= nwg) return false;
        int wgid = (int)L; { const int q = nwg / NXCD, r = nwg % NXCD, xcd = wgid % NXCD, off = wgid / NXCD; wgid = (xcd < r ? xcd * (q + 1) : r * (q + 1) + (xcd - r) * q) + off; }
        const int nig = WGM * nN, gid = wgid / nig, fm = gid * WGM, gsz = (nM - fm) < WGM ? (nM - fm) : WGM;
        u.pm = fm + ((wgid % nig) % gsz); u.pn = (wgid % nig) / gsz; return true;
    }
    __device__ __forceinline__ void a_ready(const Unit&) const {}
    __device__ __forceinline__ void done(const Unit&) const {}
};

__device__ __forceinline__ unsigned cvt_pk_bf16(float lo, float hi) { unsigned r; asm volatile("v_cvt_pk_bf16_f32 %0, %1, %2" : "=v"(r) : "v"(lo), "v"(hi)); return r; }
typedef unsigned u32x2 __attribute__((ext_vector_type(2)));
struct EpiP {
    static constexpr bool PERM = true, AFTER_DRAIN = false;
    bf16_t* O; int ldc;
    __device__ __forceinline__ void operator()(const f32x4 (&acc)[2][2][4][2], const Unit& u, int wr, int wc, int fr, int fq) const {
        const int row0 = u.pm * BM + wr * 64 + fr, col0 = u.pn * BM + wc * 32 + 8 * fq;
#pragma unroll
        for (int ai = 0; ai < 2; ++ai)
#pragma unroll
            for (int m = 0; m < 4; ++m) { bf16_t* rowp = O + (size_t)(row0 + ai * HALF + m * 16) * ldc + col0;
#pragma unroll
                for (int bj = 0; bj < 2; ++bj) { const f32x4 v0 = acc[ai][bj][m][0], v1 = acc[ai][bj][m][1];
                    u32x4 w; w.x = cvt_pk_bf16(v0[0], v0[1]); w.y = cvt_pk_bf16(v0[2], v0[3]); w.z = cvt_pk_bf16(v1[0], v1[1]); w.w = cvt_pk_bf16(v1[2], v1[3]);
                    *(u32x4*)(rowp + bj * HALF) = w; } }
    }
};
struct EpiOut {
    static constexpr bool PERM = false, AFTER_DRAIN = false;
    const float* x; bf16_t* hb; float* ssq;
    __device__ __forceinline__ void operator()(const f32x4 (&acc)[2][2][4][2], const Unit& u, int wr, int wc, int fr, int fq) const {
        const int row0 = u.pm * BM + wr * 64 + fr, col0 = u.pn * BM + wc * 32 + 4 * fq;
#pragma unroll
        for (int ai = 0; ai < 2; ++ai)
#pragma unroll
            for (int m = 0; m < 4; ++m) { const int row = row0 + ai * HALF + m * 16; const size_t off = (size_t)row * 1024 + col0; float s = 0.f;
#pragma unroll
                for (int bj = 0; bj < 2; ++bj)
#pragma unroll
                    for (int n = 0; n < 2; ++n) { const size_t o = off + bj * HALF + n * 16; const f32x4 xv = *(const f32x4*)(x + o); const f32x4 hv = xv + acc[ai][bj][m][n];
                        s += (hv[0] * hv[0] + hv[1] * hv[1]) + (hv[2] * hv[2] + hv[3] * hv[3]);
                        u32x2 w; w.x = cvt_pk_bf16(hv[0], hv[1]); w.y = cvt_pk_bf16(hv[2], hv[3]); *(u32x2*)(hb + o) = w; }
                s += __shfl_xor(s, 16); s += __shfl_xor(s, 32);
                if (fq == 0) ssq[(size_t)row * 16 + u.pn * 4 + wc] = s; }
    }
};
struct EpiGU {
    static constexpr bool PERM = true, AFTER_DRAIN = false;
    const float* ssq; bf16_t* act;
    __device__ __forceinline__ void operator()(const f32x4 (&acc)[2][2][4][2], const Unit& u, int wr, int wc, int fr, int fq) const {
        const int row0 = u.pm * BM + wr * 64 + fr, col0 = u.pn * 128 + wc * 32 + 8 * fq;
#pragma unroll
        for (int ai = 0; ai < 2; ++ai)
#pragma unroll
            for (int m = 0; m < 4; ++m) { const int row = row0 + ai * HALF + m * 16; const f32x4* sp = (const f32x4*)(ssq + (size_t)row * 16);
                const f32x4 s0 = sp[0], s1 = sp[1], s2 = sp[2], s3 = sp[3]; const f32x4 st = (s0 + s1) + (s2 + s3);
                const float rinv = rsqrtf(((st[0] + st[1]) + (st[2] + st[3])) * (1.0f / 1024.0f) + 1e-6f);
                float a[8];
#pragma unroll
                for (int n = 0; n < 2; ++n)
#pragma unroll
                    for (int j = 0; j < 4; ++j) { const float g = acc[ai][0][m][n][j] * rinv, up = acc[ai][1][m][n][j] * rinv; a[4 * n + j] = g * __builtin_amdgcn_rcpf(1.0f + __expf(-g)) * up; }
                u32x4 w; w.x = cvt_pk_bf16(a[0], a[1]); w.y = cvt_pk_bf16(a[2], a[3]); w.z = cvt_pk_bf16(a[4], a[5]); w.w = cvt_pk_bf16(a[6], a[7]);
                *(u32x4*)(act + (size_t)row * 2816 + col0) = w; }
    }
};
struct EpiDown {
    static constexpr bool PERM = false, AFTER_DRAIN = false;
    bf16_t* hb; float* ssq;
    __device__ __forceinline__ void operator()(const f32x4 (&acc)[2][2][4][2], const Unit& u, int wr, int wc, int fr, int fq) const {
        const int row0 = u.pm * BM + wr * 64 + fr, col0 = u.pn * BM + wc * 32 + 4 * fq;
#pragma unroll
        for (int ai = 0; ai < 2; ++ai)
#pragma unroll
            for (int m = 0; m < 4; ++m) { const int row = row0 + ai * HALF + m * 16; const size_t off = (size_t)row * 1024 + col0; float s = 0.f;
#pragma unroll
                for (int bj = 0; bj < 2; ++bj)
#pragma unroll
                    for (int n = 0; n < 2; ++n) { const size_t o = off + bj * HALF + n * 16; const u32x2 xb = *(const u32x2*)(hb + o); const f32x4 xv = {__uint_as_float(xb.x << 16), __uint_as_float(xb.x & 0xffff0000u), __uint_as_float(xb.y << 16), __uint_as_float(xb.y & 0xffff0000u)}; const f32x4 hv = xv + acc[ai][bj][m][n];
                        s += (hv[0] * hv[0] + hv[1] * hv[1]) + (hv[2] * hv[2] + hv[3] * hv[3]);
                        u32x2 w; w.x = cvt_pk_bf16(hv[0], hv[1]); w.y = cvt_pk_bf16(hv[2], hv[3]); *(u32x2*)(hb + o) = w; }
                s += __shfl_xor(s, 16); s += __shfl_xor(s, 32);
                if (fq == 0) ssq[(size_t)row * 16 + u.pn * 4 + wc] = s; }
    }
};
template <class Epi, class Sched, bool ALIGN_EPI = false, bool SP2 = false>
__device__ __forceinline__ void gemm_phase(PG8_LAS unsigned char* lds, const Gemm g, const Sched& S, const Epi& E) {
    const int tid = threadIdx.x, wid = __builtin_amdgcn_readfirstlane(tid >> 6), lane = tid & 63, wr = wid >> 2, wc = wid & 3, fr = lane & 15, fq = lane >> 4;
    const int K = g.K, nt = K / BK;
    unsigned voffA[2], voffB[2];
#pragma unroll
    for (int i = 0; i < 2; ++i) { int R, C; stage_rc(tid * 16 + i * 8192, R, C); const int Rb = Epi::PERM ? ((R & ~31) + perm32(R & 31)) : R;
        voffA[i] = (unsigned)(R * K + C) * 2u; voffB[i] = (unsigned)(Rb * K + C) * 2u; }
    const size_t kstep = (size_t)(BK * 2);
    const size_t hstep = (size_t)HALF * K * 2;
    const size_t tstep = 2 * hstep;
    const unsigned ldsw = (unsigned)wid * 1024u;
    const int aoff = lds_byte(wr * 64 + fr, fq * 8), boff = lds_byte(wc * 32 + fr, fq * 8);
#define PG8_SA(b, h) (((b) * 2 + (h)) * HTB)
#define PG8_SB(b, h) ((4 + (b) * 2 + (h)) * HTB)
#define PG8_STAGE(bufoff, gbase, voff) do { _Pragma("unroll") for (int _i = 0; _i < 2; ++_i) \
        __builtin_amdgcn_global_load_lds((const unsigned*)((const char*)(gbase) + (voff)[_i]), (PG8_LAS unsigned*)(lds + (bufoff) + ldsw + _i * 8192), 16, 0, 0); } while (0)
#define PG8_LDA(dst, b, h) do { _Pragma("unroll") for (int m = 0; m < 4; ++m) _Pragma("unroll") for (int k = 0; k < 2; ++k) dst[m][k] = *(const PG8_LAS bf16x8*)(lds + PG8_SA(b, h) + aoff + m * 2048 + k * 1024); } while (0)
#define PG8_LDB(dst, b, h) do { _Pragma("unroll") for (int n = 0; n < 2; ++n) _Pragma("unroll") for (int k = 0; k < 2; ++k) dst[n][k] = *(const PG8_LAS bf16x8*)(lds + PG8_SB(b, h) + boff + n * 2048 + k * 1024); } while (0)
#define PG8_MMA(ai, bj, At, Bt) do { __builtin_amdgcn_s_setprio(1); _Pragma("unroll") for (int m = 0; m < 4; ++m) _Pragma("unroll") for (int n = 0; n < 2; ++n) _Pragma("unroll") for (int k = 0; k < 2; ++k) \
        acc[ai][bj][m][n] = __builtin_amdgcn_mfma_f32_16x16x32_bf16(Bt[n][k], At[m][k], acc[ai][bj][m][n], 0, 0, 0); __builtin_amdgcn_s_setprio(0); } while (0)
#define PG8_WAIT_V(n) asm volatile("s_waitcnt vmcnt(" #n ")" ::: "memory")
#define PG8_WAIT_L(n) asm volatile("s_waitcnt lgkmcnt(" #n ")" ::: "memory")
#define PG8_BAR __builtin_amdgcn_s_barrier()
#define PG8_SCHED __builtin_amdgcn_sched_barrier(0)
    Unit cur, nxt; int ui = 0;
    if (!S.next(0, cur)) return;
    f32x4 acc[2][2][4][2];
#pragma unroll
    for (int a = 0; a < 2; ++a)
#pragma unroll
        for (int b = 0; b < 2; ++b)
#pragma unroll
            for (int m = 0; m < 4; ++m)
#pragma unroll
                for (int n = 0; n < 2; ++n) acc[a][b][m][n] = (f32x4){0.f, 0.f, 0.f, 0.f};
    bf16x8 At[4][2], B0[2][2], B1[2][2];
    const char* cA = (const char*)g.A + (size_t)cur.pm * tstep; const char* cB = (const char*)g.Bt + (size_t)cur.pn * tstep;
    S.a_ready(cur);
    if constexpr (SP2) {
        PG8_STAGE(PG8_SB(0, 0), cB, voffB); PG8_STAGE(PG8_SB(0, 1), cB + hstep, voffB); PG8_STAGE(PG8_SA(0, 0), cA, voffA); PG8_STAGE(PG8_SA(0, 1), cA + hstep, voffA);
        if (wr == 1) PG8_BAR;
        PG8_WAIT_V(2); PG8_BAR;
        PG8_STAGE(PG8_SB(1, 0), cB + kstep, voffB); PG8_STAGE(PG8_SA(1, 0), cA + kstep, voffA); PG8_STAGE(PG8_SB(1, 1), cB + hstep + kstep, voffB);
        PG8_WAIT_V(6); PG8_BAR;
    } else {
        PG8_STAGE(PG8_SB(0, 0), cB, voffB); PG8_STAGE(PG8_SA(0, 0), cA, voffA); PG8_STAGE(PG8_SB(0, 1), cB + hstep, voffB); PG8_STAGE(PG8_SA(0, 1), cA + hstep, voffA);
        if (wr == 1) PG8_BAR;
        PG8_WAIT_V(4); PG8_BAR;
        PG8_STAGE(PG8_SB(1, 0), cB + kstep, voffB); PG8_STAGE(PG8_SA(1, 0), cA + kstep, voffA); PG8_STAGE(PG8_SB(1, 1), cB + hstep + kstep, voffB);
        PG8_WAIT_V(6); PG8_BAR;
    }
    for (;;) {
        const bool has_next = S.next(ui + 1, nxt);
        const char* nA = has_next ? (const char*)g.A + (size_t)nxt.pm * tstep : cA; const char* nB = has_next ? (const char*)g.Bt + (size_t)nxt.pn * tstep : cB;
        for (int t = 0; t < nt; t += 2) {
            const bool last = (t == nt - 2);
            const char* a1 = cA + (size_t)(t + 1) * kstep;
            const char* a2 = last ? nA : cA + (size_t)(t + 2) * kstep; const char* b2 = last ? nB : cB + (size_t)(t + 2) * kstep;
            const char* a3 = a2 + kstep; const char* b3 = b2 + kstep;
            if (last && has_next) S.a_ready(nxt);
            if constexpr (SP2) {
            PG8_LDB(B0, 0, 0); PG8_LDB(B1, 0, 1); PG8_SCHED; PG8_LDA(At, 0, 0); PG8_STAGE(PG8_SA(1, 1), a1 + hstep, voffA);
            PG8_WAIT_V(8); PG8_WAIT_L(0); PG8_BAR; PG8_MMA(0, 0, At, B0); PG8_MMA(0, 1, At, B1); PG8_BAR; PG8_SCHED;
            PG8_LDA(At, 0, 1); PG8_STAGE(PG8_SB(0, 0), b2, voffB); PG8_STAGE(PG8_SB(0, 1), b2 + hstep, voffB); PG8_STAGE(PG8_SA(0, 0), a2, voffA);
            PG8_WAIT_V(8); PG8_WAIT_L(0); PG8_BAR; PG8_MMA(1, 0, At, B0); PG8_MMA(1, 1, At, B1); PG8_BAR; PG8_SCHED;
            PG8_LDB(B0, 1, 0); PG8_LDB(B1, 1, 1); PG8_SCHED; PG8_LDA(At, 1, 0); PG8_STAGE(PG8_SA(0, 1), a2 + hstep, voffA);
            PG8_WAIT_V(8); PG8_WAIT_L(0); PG8_BAR; PG8_MMA(0, 0, At, B0); PG8_MMA(0, 1, At, B1); PG8_BAR; PG8_SCHED;
            PG8_LDA(At, 1, 1); PG8_STAGE(PG8_SB(1, 0), b3, voffB); PG8_STAGE(PG8_SB(1, 1), b3 + hstep, voffB); PG8_STAGE(PG8_SA(1, 0), a3, voffA);
            PG8_WAIT_V(8); PG8_WAIT_L(0); PG8_BAR; PG8_MMA(1, 0, At, B0); PG8_MMA(1, 1, At, B1); PG8_BAR; PG8_SCHED;
            } else {
            PG8_LDB(B0, 0, 0); PG8_SCHED; PG8_LDA(At, 0, 0); PG8_STAGE(PG8_SA(1, 1), a1 + hstep, voffA);
            PG8_WAIT_L(8); PG8_BAR; PG8_WAIT_L(0); PG8_MMA(0, 0, At, B0); PG8_BAR; PG8_SCHED;
            PG8_LDB(B1, 0, 1); PG8_STAGE(PG8_SB(0, 0), b2, voffB);
            PG8_BAR; PG8_WAIT_L(0); PG8_MMA(0, 1, At, B1); PG8_BAR;
            PG8_LDA(At, 0, 1); PG8_STAGE(PG8_SA(0, 0), a2, voffA);
            PG8_BAR; PG8_WAIT_L(0); PG8_MMA(1, 0, At, B0); PG8_BAR; PG8_SCHED;
            PG8_STAGE(PG8_SB(0, 1), b2 + hstep, voffB);
            PG8_WAIT_V(6); PG8_BAR; PG8_MMA(1, 1, At, B1); PG8_BAR;
            PG8_LDB(B0, 1, 0); PG8_SCHED; PG8_LDA(At, 1, 0); PG8_STAGE(PG8_SA(0, 1), a2 + hstep, voffA);
            PG8_WAIT_L(8); PG8_BAR; PG8_WAIT_L(0); PG8_MMA(0, 0, At, B0); PG8_BAR; PG8_SCHED;
            PG8_LDB(B1, 1, 1); PG8_STAGE(PG8_SB(1, 0), b3, voffB);
            PG8_BAR; PG8_WAIT_L(0); PG8_MMA(0, 1, At, B1); PG8_BAR;
            PG8_LDA(At, 1, 1); PG8_STAGE(PG8_SA(1, 0), a3, voffA);
            PG8_BAR; PG8_WAIT_L(0); PG8_MMA(1, 0, At, B0); PG8_BAR; PG8_SCHED;
            PG8_STAGE(PG8_SB(1, 1), b3 + hstep, voffB);
            PG8_WAIT_V(6); PG8_BAR; PG8_MMA(1, 1, At, B1); PG8_BAR;
            }
        }
        if constexpr (ALIGN_EPI) { if (wr == 0) PG8_BAR; }
        if constexpr (!Epi::AFTER_DRAIN) { E(acc, cur, wr, wc, fr, fq); S.done(cur); }
        if (!has_next) break;
#pragma unroll
        for (int a = 0; a < 2; ++a)
#pragma unroll
            for (int b = 0; b < 2; ++b)
#pragma unroll
                for (int m = 0; m < 4; ++m)
#pragma unroll
                    for (int n = 0; n < 2; ++n) acc[a][b][m][n] = (f32x4){0.f, 0.f, 0.f, 0.f};
        cur = nxt; cA = nA; cB = nB; ++ui;
        if constexpr (ALIGN_EPI) { if (wr == 1) PG8_BAR; }
    }
    PG8_WAIT_V(0);
    if constexpr (!ALIGN_EPI) { if (wr == 0) PG8_BAR; }
    PG8_BAR;
    if constexpr (Epi::AFTER_DRAIN) { E.fused(acc, cur, wr, wc, fr, fq, lds, wid, lane); S.done(cur); }
#undef PG8_SA
#undef PG8_SB
#undef PG8_STAGE
#undef PG8_LDA
#undef PG8_LDB
#undef PG8_MMA
#undef PG8_WAIT_V
#undef PG8_WAIT_L
#undef PG8_BAR
#undef PG8_SCHED
}
}

#ifndef MK_N_LAUNCHES
#define MK_N_LAUNCHES 1
#endif
#ifndef REPMASK
#define REPMASK 0
#endif
#define REP(k) _Pragma("unroll") for (int rep_ = 0; rep_ < (((REPMASK) >> (k)) & 1) + 1; ++rep_)
#ifndef SKIPMASK
#define SKIPMASK 0
#endif
constexpr int NPH = 8;
constexpr int NB = 8, SEQ = 4096, DM = 1024, NMETA = 16, DIN = 3072, DRG = 512, DFF = 2816;
constexpr int MROWS = NB * SEQ;
constexpr float EPS = 1e-6f;
constexpr size_t MiB = 1u << 20;
constexpr size_t WS_WIN = 0, WS_WO = 6 * MiB, WS_WGU = 8 * MiB, WS_WD = 19 * MiB, WS_WG = 25 * MiB;
constexpr size_t WS_RGA = 26 * MiB, WS_RGH = 26 * MiB + 512 * 1024, WS_HM = 27 * MiB, WS_BT = 27 * MiB + 64 * 1024, WS_SM = 28 * MiB;
constexpr size_t WS_SSQ1 = 30 * MiB, WS_SSQ2 = 32 * MiB, WS_SL = 34 * MiB;
constexpr size_t WS_BAR = 50 * MiB;
constexpr int MISC_OFF = 131072 + 320;
constexpr size_t WS_XN = 64 * MiB;
constexpr size_t WS_Y = 128 * MiB;
constexpr size_t WS_P = 192 * MiB;
constexpr size_t WS_END = 392 * MiB;
constexpr int LDS_BYTES = 147456;

#define LAS __attribute__((address_space(3)))
typedef unsigned short bf16;
typedef float f32x4 __attribute__((ext_vector_type(4)));
typedef short bf16x8 __attribute__((ext_vector_type(8)));
typedef unsigned v4u __attribute__((ext_vector_type(4)));
typedef unsigned v2u __attribute__((ext_vector_type(2)));
__device__ __forceinline__ float bf2f(unsigned short b) { return __uint_as_float(((unsigned)b) << 16); }
__device__ __forceinline__ unsigned f2bf(float f) { unsigned u = __float_as_uint(f); return (u + 0x7fffu + ((u >> 16) & 1u)) >> 16; }
__device__ __forceinline__ unsigned pk2(float lo, float hi) { return f2bf(lo) | (f2bf(hi) << 16); }
__device__ __forceinline__ float sigm(float x) { return __builtin_amdgcn_rcpf(1.0f + __expf(-x)); }
__device__ __forceinline__ float wave_sum(float v) {
#pragma unroll
    for (int o = 1; o < 64; o <<= 1) v += __shfl_xor(v, o);
    return v;
}
#define MFMA16(a, b, c) __builtin_amdgcn_mfma_f32_16x16x32_bf16((a), (b), (c), 0, 0, 0)

__device__ __forceinline__ void p0_transpose_item(const float* W, int K, int N, bf16* WT, LAS float* scr, int item, int lane, int mode, const float* ksc) {
    const int nblk = N / 32, kb = item / nblk, nb = item % nblk, k0 = 64 * kb, n0 = 32 * nb;
    int src0 = n0;
    if (mode == 1) { const int t = n0 >> 8, c = n0 & 255; src0 = (c < 128) ? (t * 128 + c) : (DFF + t * 128 + (c - 128)); }
#pragma unroll 8
    for (int i = 0; i < 32; ++i) { const int kk = 2 * i + (lane >> 5); float v = W[(size_t)(k0 + kk) * N + src0 + (lane & 31)]; if (mode == 1) v *= ksc[k0 + kk]; scr[kk * 33 + (lane & 31)] = v; }
    asm volatile("s_waitcnt lgkmcnt(0)" ::: "memory");
    const int c = lane & 7;
#pragma unroll
    for (int j = 0; j < 4; ++j) { const int n = (lane >> 3) + 8 * j; const LAS float* s = scr + (8 * c) * 33 + n;
        v4u o; o.x = pk2(s[0 * 33], s[1 * 33]); o.y = pk2(s[2 * 33], s[3 * 33]); o.z = pk2(s[4 * 33], s[5 * 33]); o.w = pk2(s[6 * 33], s[7 * 33]);
        *(v4u*)(WT + (size_t)(n0 + n) * K + k0 + 8 * c) = o; }
    asm volatile("s_waitcnt lgkmcnt(0)" ::: "memory");
}
__device__ __forceinline__ void rms_rows2_to_bf16(const float* xrow, const float* g, bf16* orow, int lane) {
    const f32x4* xr = (const f32x4*)xrow + lane; const f32x4* gr = (const f32x4*)g + lane;
    f32x4 v[2][4]; float s[2] = {0.f, 0.f};
#pragma unroll
    for (int r = 0; r < 2; ++r)
#pragma unroll
        for (int j = 0; j < 4; ++j) v[r][j] = xr[256 * r + 64 * j];
#pragma unroll
    for (int r = 0; r < 2; ++r)
#pragma unroll
        for (int j = 0; j < 4; ++j) s[r] += (v[r][j].x * v[r][j].x + v[r][j].y * v[r][j].y) + (v[r][j].z * v[r][j].z + v[r][j].w * v[r][j].w);
    const float rinv[2] = {rsqrtf(wave_sum(s[0]) * (1.f / DM) + EPS), rsqrtf(wave_sum(s[1]) * (1.f / DM) + EPS)};
    unsigned long long* o8 = (unsigned long long*)orow + lane;
#pragma unroll
    for (int j = 0; j < 4; ++j) { const f32x4 gg = gr[64 * j];
#pragma unroll
        for (int r = 0; r < 2; ++r)
            o8[256 * r + 64 * j] = (unsigned long long)pk2(v[r][j].x * rinv[r] * gg.x, v[r][j].y * rinv[r] * gg.y) | ((unsigned long long)pk2(v[r][j].z * rinv[r] * gg.z, v[r][j].w * rinv[r] * gg.w) << 32); }
}

constexpr int RG_WAVE_LDS = 10496;
__device__ __forceinline__ float bflo(unsigned u) { return __uint_as_float(u << 16); }
__device__ __forceinline__ float bfhi(unsigned u) { return __uint_as_float(u & 0xffff0000u); }
__device__ __forceinline__ unsigned cvtpk(float lo, float hi) { unsigned r; asm volatile("v_cvt_pk_bf16_f32 %0, %1, %2" : "=v"(r) : "v"(lo), "v"(hi)); return r; }
__device__ __forceinline__ void rg_scan(LAS unsigned char* lds, const bf16* P, const bf16* Wg, const float* conv_w, const float* conv_b, const float* b_r, const float* b_i, const float* lam,
                                        float* Aseg, float* Hseg, float* hmeta, bf16* HLOC, bf16* PAC, int b, int seg, bool is_meta, int wave, int lane) {
    const int c = wave * 64 + lane;
    LAS bf16* xcb = (LAS bf16*)(lds + wave * RG_WAVE_LDS);
    LAS float* pre_r = (LAS float*)(lds + wave * RG_WAVE_LDS + 2304);
    LAS float* pre_i = pre_r + 1024;
    const float cw0 = conv_w[c], cw1 = conv_w[DRG + c], cw2 = conv_w[2 * DRG + c], cw3 = conv_w[3 * DRG + c], cb = conv_b[c];
    const float br = b_r[c], bi = b_i[c];
    const float sp = 8.0f * log1pf(__expf(-lam[c]));
    bf16x8 bw[2][4][2];
#pragma unroll
    for (int g = 0; g < 2; ++g)
#pragma unroll
        for (int nt = 0; nt < 4; ++nt)
#pragma unroll
            for (int ks = 0; ks < 2; ++ks) bw[g][nt][ks] = *(const bf16x8*)(Wg + ((size_t)(g * 8 + wave) * 64 + nt * 16 + (lane & 15)) * 64 + ks * 32 + (lane >> 4) * 8);
    float h = 0.f, pa = 1.f, xm3 = 0.f, xm2 = 0.f, xm1 = 0.f;
    const int nsb = is_meta ? 1 : 8;
    const size_t row0 = is_meta ? (size_t)MROWS : (size_t)b * SEQ + (size_t)seg * 128;
    if (!is_meta) {
        const size_t r3 = (seg == 0) ? (size_t)MROWS + 13 : row0 - 3;
        xm3 = bf2f(P[r3 * DIN + c]); xm2 = bf2f(P[(r3 + 1) * DIN + c]); xm1 = bf2f(P[(r3 + 2) * DIN + c]);
    }
    for (int sb = 0; sb < nsb; ++sb) {
        const size_t rb = row0 + (size_t)sb * 16;
        float e[19], xc[16];
        e[0] = xm3; e[1] = xm2; e[2] = xm1;
#pragma unroll
        for (int i = 0; i < 16; ++i) e[3 + i] = bf2f(P[(rb + i) * DIN + c]);
        xm3 = e[16]; xm2 = e[17]; xm1 = e[18];
#pragma unroll
        for (int i = 0; i < 16; i += 2) { xc[i] = cb + cw0 * e[i] + cw1 * e[i + 1] + cw2 * e[i + 2] + cw3 * e[i + 3]; xc[i + 1] = cb + cw0 * e[i + 1] + cw1 * e[i + 2] + cw2 * e[i + 3] + cw3 * e[i + 4];
            const unsigned pk = cvtpk(xc[i], xc[i + 1]); xcb[i * 72 + lane] = (bf16)(pk & 0xffffu); xcb[(i + 1) * 72 + lane] = (bf16)(pk >> 16); }
        asm volatile("s_waitcnt lgkmcnt(0)" ::: "memory"); __builtin_amdgcn_wave_barrier();
        bf16x8 af[2];
#pragma unroll
        for (int ks = 0; ks < 2; ++ks) af[ks] = *(const LAS bf16x8*)(xcb + (lane & 15) * 72 + ks * 32 + (lane >> 4) * 8);
#pragma unroll
        for (int g = 0; g < 2; ++g)
#pragma unroll
            for (int nt = 0; nt < 4; ++nt) { f32x4 acc = {0.f, 0.f, 0.f, 0.f};
#pragma unroll
                for (int ks = 0; ks < 2; ++ks) acc = MFMA16(af[ks], bw[g][nt][ks], acc);
                LAS float* pre = g ? pre_i : pre_r;
#pragma unroll
                for (int j = 0; j < 4; ++j) pre[((lane >> 4) * 4 + j) * 64 + nt * 16 + (lane & 15)] = acc[j]; }
        asm volatile("s_waitcnt lgkmcnt(0)" ::: "memory"); __builtin_amdgcn_wave_barrier();
        float hv[16], pv[16];
#pragma unroll
        for (int i = 0; i < 16; ++i) {
            const float r = sigm(pre_r[i * 64 + lane] + br), ig = sigm(pre_i[i * 64 + lane] + bi);
            const float la = -sp * r, a = __expf(la), x2 = 2.0f * la;
            const float poly = -x2 * (1.0f + x2 * 0.5f * (1.0f + x2 * (1.0f / 3.0f) * (1.0f + x2 * 0.25f * (1.0f + x2 * 0.2f * (1.0f + x2 * (1.0f / 6.0f))))));
            const float om = (x2 > -0.25f) ? poly : (1.0f - a * a);
            h = a * h + __builtin_amdgcn_sqrtf(om) * (ig * xc[i]); pa *= a; hv[i] = h; pv[i] = pa;
        }
        asm volatile("s_waitcnt lgkmcnt(0)" ::: "memory"); __builtin_amdgcn_wave_barrier();
        if (!is_meta) {
#pragma unroll
            for (int i = 0; i < 16; i += 2) { const unsigned hp = cvtpk(hv[i], hv[i + 1]), pp = cvtpk(pv[i], pv[i + 1]);
                HLOC[(rb + i) * DRG + c] = (bf16)(hp & 0xffffu); HLOC[(rb + i + 1) * DRG + c] = (bf16)(hp >> 16);
                PAC[(rb + i) * DRG + c] = (bf16)(pp & 0xffffu); PAC[(rb + i + 1) * DRG + c] = (bf16)(pp >> 16); }
        }
    }
    if (is_meta) hmeta[c] = h; else { Aseg[(size_t)(b * 32 + seg) * DRG + c] = pa; Hseg[(size_t)(b * 32 + seg) * DRG + c] = h; }
}
__device__ __forceinline__ void rg_final(LAS unsigned char* lds, const bf16* P, const bf16* HLOC, const bf16* PAC, const float* Aseg, const float* Hseg, const float* hmeta, const float* gnorm, bf16* Y,
                                         int b, int seg, int tid, int wave, int lane) {
    LAS float* hin = (LAS float*)lds;
    { float h = hmeta[tid]; const float* ap = Aseg + (size_t)b * 32 * DRG + tid; const float* hp = Hseg + (size_t)b * 32 * DRG + tid;
#pragma unroll 8
      for (int j = 0; j < seg; ++j) h = ap[(size_t)j * DRG] * h + hp[(size_t)j * DRG];
      hin[tid] = h; }
    __syncthreads();
    const f32x4 h0 = *(const LAS f32x4*)(hin + 8 * lane), h1 = *(const LAS f32x4*)(hin + 8 * lane + 4);
    const f32x4 g0 = *(const f32x4*)(gnorm + 8 * lane), g1 = *(const f32x4*)(gnorm + 8 * lane + 4);
    const float hi8[8] = {h0.x, h0.y, h0.z, h0.w, h1.x, h1.y, h1.z, h1.w}, gn8[8] = {g0.x, g0.y, g0.z, g0.w, g1.x, g1.y, g1.z, g1.w};
#pragma unroll 4
    for (int i = 0; i < 16; ++i) { const size_t row = (size_t)b * SEQ + (size_t)seg * 128 + wave * 16 + i;
        const v4u hl = *(const v4u*)(HLOC + row * DRG + 8 * lane), pc = *(const v4u*)(PAC + row * DRG + 8 * lane), gv = *(const v4u*)(P + row * DIN + DRG + 8 * lane);
        float y[8]; float s = 0.f;
#pragma unroll
        for (int q = 0; q < 4; ++q) { const float hA = bflo(hl[q]) + bflo(pc[q]) * hi8[2 * q], hB = bfhi(hl[q]) + bfhi(pc[q]) * hi8[2 * q + 1]; const float gA = bflo(gv[q]), gB = bfhi(gv[q]);
            y[2 * q] = gA * sigm(1.5957691216f * (gA + 0.044715f * gA * gA * gA)) * hA; y[2 * q + 1] = gB * sigm(1.5957691216f * (gB + 0.044715f * gB * gB * gB)) * hB;
            s += y[2 * q] * y[2 * q] + y[2 * q + 1] * y[2 * q + 1]; }
        const float rinv = rsqrtf(wave_sum(s) * (1.0f / DRG) + EPS);
        v4u o;
#pragma unroll
        for (int q = 0; q < 4; ++q) o[q] = cvtpk(y[2 * q] * rinv * gn8[2 * q], y[2 * q + 1] * rinv * gn8[2 * q + 1]);
        *(v4u*)(Y + row * DM + 8 * lane) = o; }
}

constexpr int HG_QT = 0, HG_KH = 17408, HG_KHT = 34816, HG_VT = 53248, HG_ST = 71680, HG_AM = 106496, HG_GS = 115712, HG_EB = 119808, HG_SQ = 120320;
template <bool FINAL>
__device__ __forceinline__ void hg_run(LAS unsigned char* lds, const bf16* P, const float* Lb, const float* gnorm, float* Sloc, float* Btot, float* Smeta, bf16* Y,
                                       int b, int h, int sc, bool is_meta, int tid, int wave, int lane) {
    LAS bf16* Qt = (LAS bf16*)(lds + HG_QT); LAS bf16* Kh = (LAS bf16*)(lds + HG_KH); LAS bf16* KhT = (LAS bf16*)(lds + HG_KHT); LAS bf16* VT = (LAS bf16*)(lds + HG_VT);
    LAS bf16* St = (LAS bf16*)(lds + HG_ST); LAS bf16* Am = (LAS bf16*)(lds + HG_AM); LAS float* gpr = (LAS float*)(lds + HG_GS); LAS float* eb = (LAS float*)(lds + HG_EB); LAS float* ssqp = (LAS float*)(lds + HG_SQ);
    typedef float f32x2 __attribute__((ext_vector_type(2)));
    const int g = wave, k0 = 2 * lane, lr = lane & 15, lq = lane >> 4;
    const float lb0 = __builtin_amdgcn_rcpf(1.0f + __expf(Lb[DRG + h * 128 + k0] - Lb[h * 128 + k0]));
    const float lb1 = __builtin_amdgcn_rcpf(1.0f + __expf(Lb[DRG + h * 128 + k0 + 1] - Lb[h * 128 + k0 + 1]));
    const int item = (b * 4 + h) * 8 + sc;
    const int tt = wave & 3, vh = wave >> 2;
    f32x4 S[8];
#pragma unroll
    for (int tv = 0; tv < 8; ++tv) S[tv] = (f32x4){0.f, 0.f, 0.f, 0.f};
    float gnv[4] = {0.f, 0.f, 0.f, 0.f};
    if (FINAL) {
#pragma unroll
        for (int q = 0; q < 4; ++q) gnv[q] = gnorm[16 * (4 * vh + q) + lr];
#pragma unroll
        for (int tv = 0; tv < 8; ++tv) S[tv] = *(const f32x4*)(Smeta + (size_t)h * 16384 + ((wave * 8 + tv) * 64 + lane) * 4);
        for (int jj = 0; jj < sc; ++jj) { const int it = (b * 4 + h) * 8 + jj;
            const f32x4 d4 = *(const f32x4*)(Btot + (size_t)it * 128 + 16 * wave + 4 * lq); const f32x4 d = {__expf(d4.x), __expf(d4.y), __expf(d4.z), __expf(d4.w)};
#pragma unroll
            for (int tv = 0; tv < 8; ++tv) { const f32x4 L = *(const f32x4*)(Sloc + (size_t)it * 16384 + ((wave * 8 + tv) * 64 + lane) * 4); S[tv] = d * S[tv] + L; } }
#pragma unroll
        for (int tv = 0; tv < 8; ++tv) { v2u w; w.x = cvtpk(S[tv][0], S[tv][1]); w.y = cvtpk(S[tv][2], S[tv][3]); *(LAS v2u*)(St + (16 * tv + lr) * 136 + 16 * wave + 4 * lq) = w; }
    }
    float btot0 = 0.f, btot1 = 0.f;
    const int nch = is_meta ? 1 : 8, nvalid = is_meta ? NMETA : 64;
    const size_t rowbase0 = is_meta ? (size_t)MROWS : (size_t)b * SEQ + (size_t)sc * 512;
    unsigned rf[8], ri[8], rq[8];
#define HG_LOAD(rb_) do { _Pragma("unroll") for (int i = 0; i < 8; ++i) { const bool valid = (8 * g + i) < nvalid; const bf16* pr = P + ((rb_) + (valid ? 8 * g + i : 0)) * DIN + h * 128 + k0; \
        rf[i] = *(const unsigned*)(pr + 1536); ri[i] = valid ? *(const unsigned*)(pr + 2048) : 0u; if (FINAL) rq[i] = *(const unsigned*)(pr + 1024); } } while (0)
    HG_LOAD(rowbase0);
    for (int ch = 0; ch < nch; ++ch) {
        const size_t rowbase = rowbase0 + (size_t)ch * 64;
        unsigned short hgr[16];
        if (FINAL) {
#pragma unroll
            for (int j = 0; j < 4; ++j)
#pragma unroll
                for (int q = 0; q < 4; ++q) hgr[j * 4 + q] = P[(rowbase + 16 * tt + 4 * lq + j) * DIN + 2560 + h * 128 + 16 * (4 * vh + q) + lr];
        }
        float cpA[8], cpB[8], kA[8], kB[8], qA[8], qB[8]; float ca = 1.f, cb = 1.f;
#pragma unroll
        for (int i = 0; i < 8; ++i) { const bool valid = (8 * g + i) < nvalid;
            float fa = lb0 + (1.0f - lb0) * sigm(bflo(rf[i])), fb = lb1 + (1.0f - lb1) * sigm(bfhi(rf[i]));
            fa = valid ? fa : 1.0f; fb = valid ? fb : 1.0f;
            ca *= fa; cb *= fb; cpA[i] = ca; cpB[i] = cb; kA[i] = 1.0f - fa; kB[i] = 1.0f - fb;
            if (FINAL) { const float q0 = bflo(rq[i]), q1 = bfhi(rq[i]); qA[i] = q0 * sigm(q0); qB[i] = q1 * sigm(q1); } }
        *(LAS f32x2*)(gpr + g * 128 + k0) = (f32x2){ca, cb};
        __syncthreads();
        float pa = 1.f, pb = 1.f, tota = 1.f, totb = 1.f;
#pragma unroll
        for (int gg = 0; gg < 8; ++gg) { const f32x2 v = *(const LAS f32x2*)(gpr + gg * 128 + k0); tota *= v.x; totb *= v.y; pa *= (gg < g) ? v.x : 1.0f; pb *= (gg < g) ? v.y : 1.0f; }
        unsigned kpA[4], kpB[4], vpA[4], vpB[4];
#pragma unroll
        for (int i = 0; i < 8; i += 2) { const float ca0 = pa * cpA[i], ca1 = pa * cpA[i + 1], cb0 = pb * cpB[i], cb1 = pb * cpB[i + 1];
            const unsigned ka = cvtpk(kA[i] * __builtin_amdgcn_rcpf(ca0), kA[i + 1] * __builtin_amdgcn_rcpf(ca1)), kb = cvtpk(kB[i] * __builtin_amdgcn_rcpf(cb0), kB[i + 1] * __builtin_amdgcn_rcpf(cb1));
            kpA[i >> 1] = ka; kpB[i >> 1] = kb;
            vpA[i >> 1] = (ri[i] & 0xffffu) | (ri[i + 1] << 16); vpB[i >> 1] = (ri[i] >> 16) | (ri[i + 1] & 0xffff0000u);
            if (FINAL) { *(LAS unsigned*)(Kh + (8 * g + i) * 136 + k0) = (ka & 0xffffu) | (kb << 16); *(LAS unsigned*)(Kh + (8 * g + i + 1) * 136 + k0) = (ka >> 16) | (kb & 0xffff0000u);
                *(LAS unsigned*)(Qt + (8 * g + i) * 136 + k0) = cvtpk(qA[i] * ca0, qB[i] * cb0); *(LAS unsigned*)(Qt + (8 * g + i + 1) * 136 + k0) = cvtpk(qA[i + 1] * ca1, qB[i + 1] * cb1); } }
        *(LAS v4u*)(KhT + k0 * 72 + 8 * g) = (v4u){kpA[0], kpA[1], kpA[2], kpA[3]}; *(LAS v4u*)(KhT + (k0 + 1) * 72 + 8 * g) = (v4u){kpB[0], kpB[1], kpB[2], kpB[3]};
        *(LAS v4u*)(VT + k0 * 72 + 8 * g) = (v4u){vpA[0], vpA[1], vpA[2], vpA[3]}; *(LAS v4u*)(VT + (k0 + 1) * 72 + 8 * g) = (v4u){vpB[0], vpB[1], vpB[2], vpB[3]};
        if (g == 0) *(LAS f32x2*)(eb + k0) = (f32x2){tota, totb};
        if (!FINAL) { btot0 += __logf(tota); btot1 += __logf(totb); }
        __syncthreads();
        if (ch + 1 < nch) HG_LOAD(rowbase + 64);
        if (FINAL) {
            { const int ta = wave >> 1;
#pragma unroll
              for (int q = 0; q < 2; ++q) { const int ts = 2 * (wave & 1) + q; f32x4 acc = {0.f, 0.f, 0.f, 0.f};
#pragma unroll
                for (int ks = 0; ks < 4; ++ks) { const bf16x8 a = *(const LAS bf16x8*)(Qt + (16 * ta + lr) * 136 + ks * 32 + lq * 8); const bf16x8 bb = *(const LAS bf16x8*)(Kh + (16 * ts + lr) * 136 + ks * 32 + lq * 8); acc = MFMA16(a, bb, acc); }
#pragma unroll
                for (int j = 0; j < 4; ++j) { const int t = 16 * ta + 4 * lq + j, s = 16 * ts + lr; Am[t * 72 + s] = (bf16)f2bf((s <= t) ? acc[j] : 0.f); } } }
            __syncthreads();
            f32x4 o[4];
#pragma unroll
            for (int q = 0; q < 4; ++q) o[q] = (f32x4){0.f, 0.f, 0.f, 0.f};
#pragma unroll
            for (int ks = 0; ks < 4; ++ks) { const bf16x8 a = *(const LAS bf16x8*)(Qt + (16 * tt + lr) * 136 + ks * 32 + lq * 8);
#pragma unroll
                for (int q = 0; q < 4; ++q) { const bf16x8 bb = *(const LAS bf16x8*)(St + (16 * (4 * vh + q) + lr) * 136 + ks * 32 + lq * 8); o[q] = MFMA16(a, bb, o[q]); } }
#pragma unroll
            for (int ks = 0; ks < 2; ++ks) { const bf16x8 a = *(const LAS bf16x8*)(Am + (16 * tt + lr) * 72 + ks * 32 + lq * 8);
#pragma unroll
                for (int q = 0; q < 4; ++q) { const bf16x8 bb = *(const LAS bf16x8*)(VT + (16 * (4 * vh + q) + lr) * 72 + ks * 32 + lq * 8); o[q] = MFMA16(a, bb, o[q]); } }
#pragma unroll
            for (int j = 0; j < 4; ++j) { float p = (o[0][j] * o[0][j] + o[1][j] * o[1][j]) + (o[2][j] * o[2][j] + o[3][j] * o[3][j]);
                p += __shfl_xor(p, 1); p += __shfl_xor(p, 2); p += __shfl_xor(p, 4); p += __shfl_xor(p, 8);
                if (lr == 0) ssqp[vh * 64 + 16 * tt + 4 * lq + j] = p; }
            __syncthreads();
#pragma unroll
            for (int j = 0; j < 4; ++j) { const int t = 16 * tt + 4 * lq + j; const float rinv = rsqrtf((ssqp[t] + ssqp[64 + t]) * (1.0f / 128.0f) + EPS); const size_t row = rowbase + t;
#pragma unroll
                for (int q = 0; q < 4; ++q) { const int v = 16 * (4 * vh + q) + lr; const float hgv = bf2f(hgr[j * 4 + q]);
                    Y[row * DM + DRG + h * 128 + v] = (bf16)f2bf(o[q][j] * rinv * gnv[q] * (hgv * sigm(hgv))); } }
        }
#pragma unroll
        for (int ks = 0; ks < 2; ++ks) { const bf16x8 a = *(const LAS bf16x8*)(KhT + (16 * wave + lr) * 72 + ks * 32 + lq * 8);
#pragma unroll
            for (int tv = 0; tv < 8; ++tv) { const bf16x8 bb = *(const LAS bf16x8*)(VT + (16 * tv + lr) * 72 + ks * 32 + lq * 8); S[tv] = MFMA16(a, bb, S[tv]); } }
        { const f32x4 e4 = *(const LAS f32x4*)(eb + 16 * wave + 4 * lq);
#pragma unroll
          for (int tv = 0; tv < 8; ++tv) S[tv] = S[tv] * e4; }
        if (FINAL) {
#pragma unroll
            for (int tv = 0; tv < 8; ++tv) { v2u w; w.x = cvtpk(S[tv][0], S[tv][1]); w.y = cvtpk(S[tv][2], S[tv][3]); *(LAS v2u*)(St + (16 * tv + lr) * 136 + 16 * wave + 4 * lq) = w; }
        }
    }
#undef HG_LOAD
    if (!FINAL) {
        float* dst = is_meta ? (Smeta + (size_t)h * 16384) : (Sloc + (size_t)item * 16384);
#pragma unroll
        for (int tv = 0; tv < 8; ++tv) *(f32x4*)(dst + ((wave * 8 + tv) * 64 + lane) * 4) = S[tv];
        if (!is_meta && g == 0) *(f32x2*)(Btot + (size_t)item * 128 + k0) = (f32x2){btot0, btot1};
    }
}

#define XB_TMO      128
#define XB_XCNT(j)  (256  + 64 * (j))
#define XB_XSUB(j)  (1280 + 64 * (j))
#define XB_XGEN(j)  (2304 + 64 * (j))
#define XB_TOP      3328
#define XB_TOPGEN   3392
#define XCD_BAR_WORDS 3456
#define XB_SPIN_CAP (1u << 18)

__device__ __forceinline__ unsigned xb_ld(unsigned* p)              { return __hip_atomic_load(p, __ATOMIC_RELAXED, __HIP_MEMORY_SCOPE_AGENT); }
__device__ __forceinline__ unsigned xb_add(unsigned* p, unsigned v) { return __hip_atomic_fetch_add(p, v, __ATOMIC_RELAXED, __HIP_MEMORY_SCOPE_AGENT); }
__device__ __forceinline__ unsigned xb_xcc_id() { return (unsigned)__builtin_amdgcn_s_getreg((3 << 11) | 20) & 0xFu; }
#define XB_SPIN(cond, bar) do { unsigned _sp = 0; while (cond) { __builtin_amdgcn_s_sleep(1); \
    if ((++_sp & 255u) == 0u) { if (xb_ld(&(bar)[XB_TMO])) break; if (_sp > XB_SPIN_CAP) { atomicAdd(&(bar)[XB_TMO], 1u); break; } } } } while (0)

struct XcdBarrier {
    unsigned* bar; unsigned x;
    volatile LAS unsigned* st;
};

__device__ __forceinline__ XcdBarrier xcd_barrier_post(unsigned* bar, volatile LAS unsigned* st) {
    XcdBarrier b; b.bar = bar; b.x = xb_xcc_id(); b.st = st;
    if (threadIdx.x == 0) (void)xb_add(&bar[XB_XCNT(b.x)], 1u);
    return b;
}
__device__ __forceinline__ void xcd_barrier_complete(unsigned* bar, unsigned x, unsigned& nloc, unsigned& nx) {
    const unsigned G = gridDim.x * gridDim.y * gridDim.z;
    unsigned sum, cnt, mine, sp = 0u;
    for (;;) {
        sum = 0u; cnt = 0u; mine = 0u;
#pragma unroll
        for (unsigned j = 0; j < 16; ++j) { const unsigned c = xb_ld(&bar[XB_XCNT(j)]); sum += c; cnt += (c > 0u) ? 1u : 0u; mine = (j == x) ? c : mine; }
        if (sum == G) break;
        __builtin_amdgcn_s_sleep(1);
        if ((++sp & 255u) == 0u) { if (xb_ld(&bar[XB_TMO])) break; if (sp > XB_SPIN_CAP) { atomicAdd(&bar[XB_TMO], 1u); break; } }
    }
    nloc = mine > 0u ? mine : 1u; nx = cnt > 0u ? cnt : 1u;
}

__device__ __forceinline__ void xcd_barrier(const XcdBarrier& b) {
    asm volatile("s_waitcnt vmcnt(0)" ::: "memory");
    __syncthreads();
    if (threadIdx.x == 0) {
        unsigned* bar = b.bar;
        __builtin_amdgcn_s_waitcnt(0);
        unsigned nloc = b.st[0], nx = b.st[1];
        if (nloc == 0u) { xcd_barrier_complete(bar, b.x, nloc, nx); b.st[0] = nloc; b.st[1] = nx; }
        const unsigned old = xb_add(&bar[XB_XSUB(b.x)], 1u);
        const unsigned gen = old / nloc;
        if (old + 1u == (gen + 1u) * nloc) {
            __builtin_amdgcn_fence(__ATOMIC_RELEASE, "agent");
            asm volatile("s_waitcnt vmcnt(0)" ::: "memory");
            const unsigned og = xb_add(&bar[XB_TOP], 1u);
            const unsigned tg = og / nx;
            if (og + 1u == (tg + 1u) * nx) xb_add(&bar[XB_TOPGEN], 1u);
            else XB_SPIN(xb_ld(&bar[XB_TOPGEN]) == tg, bar);
            __builtin_amdgcn_fence(__ATOMIC_ACQUIRE, "agent");
            xb_add(&bar[XB_XGEN(b.x)], 1u);
            asm volatile("s_waitcnt vmcnt(0)" ::: "memory");
        } else {
            XB_SPIN(xb_ld(&bar[XB_XGEN(b.x)]) == gen, bar);
            __builtin_amdgcn_fence(__ATOMIC_ACQUIRE, "agent");
            asm volatile("s_waitcnt vmcnt(0)" ::: "memory");
        }
    }
    __syncthreads();
}

struct Args { const float* in[19]; float* out; unsigned char* ws; int ph_lo, ph_hi; };
__global__ void __launch_bounds__(512, 2) fwd_megakernel(Args args) {
    extern __shared__ __attribute__((aligned(16))) unsigned char lds_raw[];
    LAS unsigned char* lds = (LAS unsigned char*)lds_raw;
    cg::grid_group grid = cg::this_grid();
    const int tid = threadIdx.x, lane = tid & 63, wave = __builtin_amdgcn_readfirstlane(tid >> 6);
    const int G = gridDim.x, bx = blockIdx.x;
    unsigned char* ws = args.ws;
    const float* x = args.in[0]; const float* meta = args.in[1]; const float* mix_g = args.in[2]; const float* w_in = args.in[3];
    const float* conv_w = args.in[4]; const float* conv_b = args.in[5]; const float* w_rg = args.in[6]; const float* b_rg = args.in[7];
    const float* w_ig = args.in[8]; const float* b_ig = args.in[9]; const float* lam = args.in[10]; const float* rg_g = args.in[11];
    const float* hg_lb = args.in[12]; const float* hg_g = args.in[13]; const float* w_out = args.in[14]; const float* ffn_g = args.in[15];
    const float* w_gu = args.in[16]; const float* w_down = args.in[17]; const float* fin_g = args.in[18];
    bf16* Win_t = (bf16*)(ws + WS_WIN); bf16* Wo_t = (bf16*)(ws + WS_WO); bf16* Wgu_t = (bf16*)(ws + WS_WGU); bf16* Wd_t = (bf16*)(ws + WS_WD); bf16* Wg_t = (bf16*)(ws + WS_WG);
    float* Aseg = (float*)(ws + WS_RGA); float* Hseg = (float*)(ws + WS_RGH); float* hmeta = (float*)(ws + WS_HM); float* Btot = (float*)(ws + WS_BT); float* Smeta = (float*)(ws + WS_SM);
    float* SSQ1 = (float*)(ws + WS_SSQ1); float* SSQ2 = (float*)(ws + WS_SSQ2); float* Sloc = (float*)(ws + WS_SL);
    bf16* XN = (bf16*)(ws + WS_XN); bf16* H1B = (bf16*)(ws + WS_XN); bf16* HLOC = (bf16*)(ws + WS_XN); bf16* PAC = (bf16*)(ws + WS_XN + 32 * MiB); bf16* Y = (bf16*)(ws + WS_Y); bf16* P = (bf16*)(ws + WS_P); bf16* ACT = (bf16*)(ws + WS_P);
    float* out = args.out;
    const int lo = args.ph_lo, hi = args.ph_hi;
    volatile LAS unsigned* misc = (volatile LAS unsigned*)(lds + MISC_OFF);
    if (tid < 2) misc[tid] = 0u;
    __syncthreads();
    (void)xcd_barrier_post((unsigned*)(ws + WS_BAR), misc);
    if (hi > 1000) grid.sync();
#define IN(k) (lo <= (k) && (k) < hi)
#define GBAR() do { XcdBarrier b_; b_.bar = (unsigned*)(args.ws + WS_BAR); b_.x = xb_xcc_id(); b_.st = (volatile LAS unsigned*)(lds + MISC_OFF); xcd_barrier(b_); } while (0)
#define SEAM(k) do { if (IN(k) && IN((k) + 1)) GBAR(); } while (0)

    REP(0) if (IN(0) && !(SKIPMASK & 1)) { if (rep_) GBAR();
        const bool split = G > 48;
        const int gw = split ? (bx - 24) * 8 + wave : bx * 8 + wave, NGW = split ? (G - 24) * 8 : G * 8;
        if (bx < 24) {
            LAS float* um = (LAS float*)lds;
            LAS float* red = (LAS float*)(lds + 65536);
#pragma unroll
            for (int r = 0; r < 2; ++r) { const int m = wave * 2 + r; const f32x4* xr = (const f32x4*)(meta + (size_t)m * DM) + lane; const f32x4* gr = (const f32x4*)mix_g + lane;
                f32x4 v[4]; float s = 0.f;
#pragma unroll
                for (int j = 0; j < 4; ++j) { v[j] = xr[64 * j]; s += (v[j].x * v[j].x + v[j].y * v[j].y) + (v[j].z * v[j].z + v[j].w * v[j].w); }
                const float rinv = rsqrtf(wave_sum(s) * (1.f / DM) + EPS);
#pragma unroll
                for (int j = 0; j < 4; ++j) { const f32x4 gg = gr[64 * j]; const int k0 = 256 * j + 4 * lane;
                    um[(k0 + 0) * 16 + m] = v[j].x * rinv * gg.x; um[(k0 + 1) * 16 + m] = v[j].y * rinv * gg.y; um[(k0 + 2) * 16 + m] = v[j].z * rinv * gg.z; um[(k0 + 3) * 16 + m] = v[j].w * rinv * gg.w; } }
            __syncthreads();
            const int kg = tid >> 7, nl = tid & 127, n = bx * 128 + nl;
            float acc[16];
#pragma unroll
            for (int m = 0; m < 16; ++m) acc[m] = 0.f;
#pragma unroll 8
            for (int kk = kg * 256; kk < kg * 256 + 256; ++kk) { const float w = w_in[(size_t)kk * DIN + n]; const LAS f32x4* u4 = (const LAS f32x4*)(um + kk * 16);
#pragma unroll
                for (int q = 0; q < 4; ++q) { const f32x4 uv = u4[q]; acc[4 * q + 0] += w * uv.x; acc[4 * q + 1] += w * uv.y; acc[4 * q + 2] += w * uv.z; acc[4 * q + 3] += w * uv.w; } }
#pragma unroll
            for (int m = 0; m < 16; ++m) red[(kg * 16 + m) * 128 + nl] = acc[m];
            __syncthreads();
            for (int o = tid; o < 2048; o += 512) { const int m = o >> 7, n2 = o & 127;
                const float s = (red[(0 * 16 + m) * 128 + n2] + red[(1 * 16 + m) * 128 + n2]) + (red[(2 * 16 + m) * 128 + n2] + red[(3 * 16 + m) * 128 + n2]);
                P[(size_t)(MROWS + m) * DIN + bx * 128 + n2] = (bf16)f2bf(s); }
            __syncthreads();
        }
        if (!split || bx >= 24) {
        LAS float* scr = (LAS float*)(lds + wave * 16384);
        constexpr int I_IN = (DM / 64) * (DIN / 32), I_O = (DM / 64) * (DM / 32), I_GU = (DM / 64) * (2 * DFF / 32), I_D = (DFF / 64) * (DM / 32);
        constexpr int NITEMS = I_IN + I_O + I_GU + I_D;
        for (int it = gw; it < NITEMS; it += NGW) {
            int r = it;
            if (r < I_IN) { p0_transpose_item(w_in, DM, DIN, Win_t, scr, r, lane, 0, nullptr); continue; } r -= I_IN;
            if (r < I_O) { p0_transpose_item(w_out, DM, DM, Wo_t, scr, r, lane, 0, nullptr); continue; } r -= I_O;
            if (r < I_GU) { p0_transpose_item(w_gu, DM, 2 * DFF, Wgu_t, scr, r, lane, 1, ffn_g); continue; } r -= I_GU;
            p0_transpose_item(w_down, DFF, DM, Wd_t, scr, r, lane, 0, nullptr);
        }
        for (int i = gw * 64 + lane; i < 2 * 8 * 64 * 64; i += NGW * 64) {
            const int gt = i >> 15, hh = (i >> 12) & 7, j = (i >> 6) & 63, ii = i & 63;
            Wg_t[i] = (bf16)f2bf((gt ? w_ig : w_rg)[hh * 4096 + ii * 64 + j]); }
        for (int m = 2 * gw; m < MROWS; m += 2 * NGW) rms_rows2_to_bf16(x + (size_t)m * DM, mix_g, XN + (size_t)m * DM, lane);
        }
    }
    SEAM(0);
#ifdef EXTRA_SYNCS
    for (int q_ = 0; q_ < EXTRA_SYNCS; ++q_) GBAR();
#endif
    REP(1) if (IN(1) && !(SKIPMASK & 2)) { if (rep_) GBAR();
        pg8::Gemm g{XN, Win_t, MROWS, DIN, DM}; pg8::StaticOrder S; S.init(MROWS, DIN, G, bx);
        pg8::EpiP E{P, DIN};
        pg8::gemm_phase<pg8::EpiP, pg8::StaticOrder, true, true>(lds, g, S, E);
    }
    SEAM(1);
    REP(2) if (IN(2) && !(SKIPMASK & 4)) { if (rep_) GBAR();
        for (int it = bx; it < 256; it += G) {
            int wv = wave, ln = lane, td = tid; asm volatile("" : "+s"(wv), "+v"(ln), "+v"(td));
#ifndef NO_RG
            rg_scan(lds, P, Wg_t, conv_w, conv_b, b_rg, b_ig, lam, Aseg, Hseg, hmeta, HLOC, PAC, it >> 5, it & 31, false, wv, ln);
            if (it == 255) rg_scan(lds, P, Wg_t, conv_w, conv_b, b_rg, b_ig, lam, Aseg, Hseg, hmeta, HLOC, PAC, 0, 0, true, wv, ln);
#endif
            __syncthreads();
#ifndef NO_HG
            hg_run<false>(lds, P, hg_lb, hg_g, Sloc, Btot, Smeta, Y, it >> 5, (it >> 3) & 3, it & 7, false, td, wv, ln);
            __syncthreads();
            if (it < 4) { hg_run<false>(lds, P, hg_lb, hg_g, Sloc, Btot, Smeta, Y, 0, it, 0, true, td, wv, ln); __syncthreads(); }
#endif
        }
    }
    SEAM(2);
    REP(3) if (IN(3) && !(SKIPMASK & 8)) { if (rep_) GBAR();
        for (int it = bx; it < 256; it += G) {
            int wv = wave, ln = lane, td = tid; asm volatile("" : "+s"(wv), "+v"(ln), "+v"(td));
#ifndef NO_RG
            rg_final(lds, P, HLOC, PAC, Aseg, Hseg, hmeta, rg_g, Y, it >> 5, it & 31, td, wv, ln);
            __syncthreads();
#endif
#ifndef NO_HG
            hg_run<true>(lds, P, hg_lb, hg_g, Sloc, Btot, Smeta, Y, it >> 5, (it >> 3) & 3, it & 7, false, td, wv, ln);
            __syncthreads();
#endif
        }
    }
    SEAM(3);
    REP(4) if (IN(4) && !(SKIPMASK & 16)) { if (rep_) GBAR();
        pg8::Gemm g{Y, Wo_t, MROWS, DM, DM}; pg8::StaticOrder S; S.init(MROWS, DM, G, bx);
        pg8::EpiOut E{x, H1B, SSQ1};
        pg8::gemm_phase<pg8::EpiOut, pg8::StaticOrder, true, true>(lds, g, S, E);
    }
    SEAM(4);
    REP(5) if (IN(5) && !(SKIPMASK & 32)) { if (rep_) GBAR();
        pg8::Gemm g{H1B, Wgu_t, MROWS, 2 * DFF, DM}; pg8::StaticOrder S; S.init(MROWS, 2 * DFF, G, bx);
        pg8::EpiGU E{SSQ1, ACT};
        pg8::gemm_phase<pg8::EpiGU, pg8::StaticOrder, true, true>(lds, g, S, E);
    }
    SEAM(5);
    REP(6) if (IN(6) && !(SKIPMASK & 64)) { if (rep_) GBAR();
        pg8::Gemm g{ACT, Wd_t, MROWS, DM, DFF}; pg8::StaticOrder S; S.init(MROWS, DM, G, bx);
        pg8::EpiDown E{H1B, SSQ2};
        pg8::gemm_phase<pg8::EpiDown, pg8::StaticOrder, true, true>(lds, g, S, E);
    }
    SEAM(6);
    REP(7) if (IN(7) && !(SKIPMASK & 128)) { if (rep_) GBAR();
        const int gw = bx * 8 + wave, NGW = G * 8;
        for (int m = gw; m < MROWS; m += NGW) {
            const float sv = (lane < 16) ? SSQ2[(size_t)m * 16 + lane] : 0.f;
            const float rinv = rsqrtf(wave_sum(sv) * (1.f / DM) + EPS);
            const float* gp = fin_g;
#pragma unroll
            for (int j = 0; j < 2; ++j) { const int c0 = (64 * j + lane) * 8; const v4u hv = *(const v4u*)(H1B + (size_t)m * DM + c0); const f32x4 ga = *(const f32x4*)(gp + c0), gb = *(const f32x4*)(gp + c0 + 4);
                f32x4 oa = {bflo(hv.x) * rinv * ga.x, bfhi(hv.x) * rinv * ga.y, bflo(hv.y) * rinv * ga.z, bfhi(hv.y) * rinv * ga.w};
                f32x4 ob = {bflo(hv.z) * rinv * gb.x, bfhi(hv.z) * rinv * gb.y, bflo(hv.w) * rinv * gb.z, bfhi(hv.w) * rinv * gb.w};
                *(f32x4*)(out + (size_t)m * DM + c0) = oa; *(f32x4*)(out + (size_t)m * DM + c0 + 4) = ob; }
        }
    }
#undef IN
#undef SEAM
}

extern "C" void kernel_launch(void* const* d_in, const int* in_sizes, int n_in, void* d_out, int out_size, void* d_ws, size_t ws_size, hipStream_t stream) {
    static int grid = 0;
    if (grid == 0) {
        if (n_in != 19 || in_sizes[0] != MROWS * DM || out_size != MROWS * DM || ws_size < WS_END) { fprintf(stderr, "kernel_launch: unexpected shapes (n_in %d, in0 %d, out %d, ws %zu)\n", n_in, n_in > 0 ? in_sizes[0] : -1, out_size, ws_size); grid = -1; return; }
        int dev = 0, cus = 0, per_cu = 0;
        hipGetDevice(&dev); hipDeviceGetAttribute(&cus, hipDeviceAttributeMultiprocessorCount, dev);
        if (hipFuncSetAttribute((const void*)fwd_megakernel, hipFuncAttributeMaxDynamicSharedMemorySize, LDS_BYTES) != hipSuccess) { fprintf(stderr, "kernel_launch: hipFuncSetAttribute failed\n"); grid = -1; return; }
        if (hipOccupancyMaxActiveBlocksPerMultiprocessor(&per_cu, (const void*)fwd_megakernel, 512, LDS_BYTES) != hipSuccess || per_cu < 1) { fprintf(stderr, "kernel_launch: occupancy query gave %d\n", per_cu); per_cu = 1; }
        (void)hipGetLastError();
        grid = cus * per_cu;
        fprintf(stderr, "kernel_launch: grid %d (cus %d x %d)\n", grid, cus, per_cu);
    }
    if (grid < 0) return;
    Args a{};
    for (int i = 0; i < 19; ++i) a.in[i] = (const float*)d_in[i];
    a.out = (float*)d_out; a.ws = (unsigned char*)d_ws;
#if MK_N_LAUNCHES == 1
    if (hipMemsetAsync((char*)d_ws + WS_BAR, 0, XCD_BAR_WORDS * 4, stream) != hipSuccess) { fprintf(stderr, "kernel_launch: memset failed\n"); return; }
    a.ph_lo = 0; a.ph_hi = NPH;
    void* kargs[] = {&a};
    hipError_t e = hipLaunchCooperativeKernel((const void*)fwd_megakernel, dim3(grid), dim3(512), kargs, LDS_BYTES, stream);
    if (e != hipSuccess) fprintf(stderr, "kernel_launch: cooperative launch failed: %s (grid %d)\n", hipGetErrorString(e), grid);
#else
    for (int p = 0; p < NPH; ++p) { a.ph_lo = p; a.ph_hi = p + 1; hipLaunchKernelGGL(fwd_megakernel, dim3(grid), dim3(512), LDS_BYTES, stream, a); }
#endif
}
```

```cpp
#include <hip/hip_runtime.h>
#include <hip/hip_cooperative_groups.h>
#include <cstdio>
#include <cstdint>
namespace cg = cooperative_groups;
namespace pg8 {
#define PG8_LAS __attribute__((address_space(3)))
typedef unsigned short bf16_t;
typedef short bf16x8 __attribute__((ext_vector_type(8)));
typedef float f32x4 __attribute__((ext_vector_type(4)));
typedef unsigned u32x4 __attribute__((ext_vector_type(4)));
constexpr int BM = 256, BK = 64, HALF = 128, HTB = HALF * BK * 2  , STAGE_BYTES = 8 * HTB, NXCD = 8, WGM = 8;

__host__ __device__ __forceinline__ int lds_byte(int r, int c) { const int st = (r >> 4) * 2 + (c >> 5), rr = r & 15, cc = c & 31, ob = rr * 64 + cc * 2; return st * 1024 + (ob ^ (((ob >> 9) & 1) << 5)); }
__host__ __device__ __forceinline__ void stage_rc(int b, int& R, int& C) { const int st = b / 1024, sb = b % 1024, swz = sb ^ (((sb >> 9) & 1) << 5); R = (st >> 1) * 16 + swz / 64; C = (st & 1) * 32 + (swz % 64) / 2; }
__host__ __device__ __forceinline__ int perm32(int rho) { const int n = rho >> 4, i = rho & 15; return 8 * (i >> 2) + 4 * n + (i & 3); }

struct Unit { int pm, pn; };
struct Gemm { const bf16_t* A; const bf16_t* Bt; int M, N, K; };

struct StaticOrder {
    int nM, nN, nwg, G, c;
    __host__ __device__ void init(int M, int N, int G_, int c_) { nM = M / BM; nN = N / BM; nwg = nM * nN; G = G_; c = c_; }
    __host__ __device__ bool next(int i, Unit& u) const {
        const long L = (long)i * G + c; if (L >= nwg) return false;
        int wgid = (int)L; { const int q = nwg / NXCD, r = nwg % NXCD, xcd = wgid % NXCD, off = wgid / NXCD; wgid = (xcd < r ? xcd * (q + 1) : r * (q + 1) + (xcd - r) * q) + off; }
        const int nig = WGM * nN, gid = wgid / nig, fm = gid * WGM, gsz = (nM - fm) < WGM ? (nM - fm) : WGM;
        u.pm = fm + ((wgid % nig) % gsz); u.pn = (wgid % nig) / gsz; return true;
    }
    __device__ __forceinline__ void a_ready(const Unit&) const {}
    __device__ __forceinline__ void done(const Unit&) const {}
};

__device__ __forceinline__ unsigned cvt_pk_bf16(float lo, float hi) { unsigned r; asm volatile("v_cvt_pk_bf16_f32 %0, %1, %2" : "=v"(r) : "v"(lo), "v"(hi)); return r; }
typedef unsigned u32x2 __attribute__((ext_vector_type(2)));
struct EpiP {
    static constexpr bool PERM = true, AFTER_DRAIN = false;
    bf16_t* O; int ldc;
    __device__ __forceinline__ void operator()(const f32x4 (&acc)[2][2][4][2], const Unit& u, int wr, int wc, int fr, int fq) const {
        const int row0 = u.pm * BM + wr * 64 + fr, col0 = u.pn * BM + wc * 32 + 8 * fq;
#pragma unroll
        for (int ai = 0; ai < 2; ++ai)
#pragma unroll
            for (int m = 0; m < 4; ++m) { bf16_t* rowp = O + (size_t)(row0 + ai * HALF + m * 16) * ldc + col0;
#pragma unroll
                for (int bj = 0; bj < 2; ++bj) { const f32x4 v0 = acc[ai][bj][m][0], v1 = acc[ai][bj][m][1];
                    u32x4 w; w.x = cvt_pk_bf16(v0[0], v0[1]); w.y = cvt_pk_bf16(v0[2], v0[3]); w.z = cvt_pk_bf16(v1[0], v1[1]); w.w = cvt_pk_bf16(v1[2], v1[3]);
                    *(u32x4*)(rowp + bj * HALF) = w; } }
    }
};
struct EpiOut {
    static constexpr bool PERM = false, AFTER_DRAIN = false;
    const float* x; bf16_t* hb; float* ssq;
    __device__ __forceinline__ void operator()(const f32x4 (&acc)[2][2][4][2], const Unit& u, int wr, int wc, int fr, int fq) const {
        const int row0 = u.pm * BM + wr * 64 + fr, col0 = u.pn * BM + wc * 32 + 4 * fq;
#pragma unroll
        for (int ai = 0; ai < 2; ++ai) {
            f32x4 xv[4][2][2];
#pragma unroll
            for (int m = 0; m < 4; ++m)
#pragma unroll
                for (int bj = 0; bj < 2; ++bj)
#pragma unroll
                    for (int n = 0; n < 2; ++n) xv[m][bj][n] = *(const f32x4*)(x + (size_t)(row0 + ai * HALF + m * 16) * 1024 + col0 + bj * HALF + n * 16);
#pragma unroll
            for (int m = 0; m < 4; ++m) { const int row = row0 + ai * HALF + m * 16; const size_t off = (size_t)row * 1024 + col0; float s = 0.f;
#pragma unroll
                for (int bj = 0; bj < 2; ++bj)
#pragma unroll
                    for (int n = 0; n < 2; ++n) { const size_t o = off + bj * HALF + n * 16; const f32x4 hv = xv[m][bj][n] + acc[ai][bj][m][n];
                        s += (hv[0] * hv[0] + hv[1] * hv[1]) + (hv[2] * hv[2] + hv[3] * hv[3]);
                        u32x2 w; w.x = cvt_pk_bf16(hv[0], hv[1]); w.y = cvt_pk_bf16(hv[2], hv[3]); *(u32x2*)(hb + o) = w; }
                s += __shfl_xor(s, 16); s += __shfl_xor(s, 32);
                if (fq == 0) ssq[(size_t)row * 16 + u.pn * 4 + wc] = s; }
            asm volatile("" ::: "memory");
        }
    }
};
struct EpiGU {
    static constexpr bool PERM = true, AFTER_DRAIN = false;
    const float* ssq; bf16_t* act;
    __device__ __forceinline__ void operator()(const f32x4 (&acc)[2][2][4][2], const Unit& u, int wr, int wc, int fr, int fq) const {
        const int row0 = u.pm * BM + wr * 64 + fr, col0 = u.pn * 128 + wc * 32 + 8 * fq;
        f32x4 sv[2][4];
#pragma unroll
        for (int ai = 0; ai < 2; ++ai)
#pragma unroll
            for (int m = 0; m < 4; ++m) sv[ai][m] = *(const f32x4*)(ssq + (size_t)(row0 + ai * HALF + m * 16) * 16 + 4 * fq);
#pragma unroll
        for (int ai = 0; ai < 2; ++ai)
#pragma unroll
            for (int m = 0; m < 4; ++m) { const int row = row0 + ai * HALF + m * 16;
                float t = (sv[ai][m][0] + sv[ai][m][1]) + (sv[ai][m][2] + sv[ai][m][3]); t += __shfl_xor(t, 16); t += __shfl_xor(t, 32);
                const float rinv = rsqrtf(t * (1.0f / 1024.0f) + 1e-6f);
                float a[8];
#pragma unroll
                for (int n = 0; n < 2; ++n)
#pragma unroll
                    for (int j = 0; j < 4; ++j) { const float g = acc[ai][0][m][n][j] * rinv, up = acc[ai][1][m][n][j] * rinv; a[4 * n + j] = g * __builtin_amdgcn_rcpf(1.0f + __expf(-g)) * up; }
                u32x4 w; w.x = cvt_pk_bf16(a[0], a[1]); w.y = cvt_pk_bf16(a[2], a[3]); w.z = cvt_pk_bf16(a[4], a[5]); w.w = cvt_pk_bf16(a[6], a[7]);
                *(u32x4*)(act + (size_t)row * 2816 + col0) = w; }
    }
};
struct EpiDown {
    static constexpr bool PERM = false, AFTER_DRAIN = false;
    bf16_t* hb; float* ssq;
    __device__ __forceinline__ void operator()(const f32x4 (&acc)[2][2][4][2], const Unit& u, int wr, int wc, int fr, int fq) const {
        const int row0 = u.pm * BM + wr * 64 + fr, col0 = u.pn * BM + wc * 32 + 4 * fq;
        u32x2 xb[2][4][2][2];
#pragma unroll
        for (int ai = 0; ai < 2; ++ai)
#pragma unroll
            for (int m = 0; m < 4; ++m)
#pragma unroll
                for (int bj = 0; bj < 2; ++bj)
#pragma unroll
                    for (int n = 0; n < 2; ++n) xb[ai][m][bj][n] = *(const u32x2*)(hb + (size_t)(row0 + ai * HALF + m * 16) * 1024 + col0 + bj * HALF + n * 16);
        asm volatile("" ::: "memory");
#pragma unroll
        for (int ai = 0; ai < 2; ++ai)
#pragma unroll
            for (int m = 0; m < 4; ++m) { const int row = row0 + ai * HALF + m * 16; const size_t off = (size_t)row * 1024 + col0; float s = 0.f;
#pragma unroll
                for (int bj = 0; bj < 2; ++bj)
#pragma unroll
                    for (int n = 0; n < 2; ++n) { const size_t o = off + bj * HALF + n * 16; const u32x2 b2 = xb[ai][m][bj][n];
                        const f32x4 xv = {__uint_as_float(b2.x << 16), __uint_as_float(b2.x & 0xffff0000u), __uint_as_float(b2.y << 16), __uint_as_float(b2.y & 0xffff0000u)}; const f32x4 hv = xv + acc[ai][bj][m][n];
                        s += (hv[0] * hv[0] + hv[1] * hv[1]) + (hv[2] * hv[2] + hv[3] * hv[3]);
                        u32x2 w; w.x = cvt_pk_bf16(hv[0], hv[1]); w.y = cvt_pk_bf16(hv[2], hv[3]); *(u32x2*)(hb + o) = w; }
                s += __shfl_xor(s, 16); s += __shfl_xor(s, 32);
                if (fq == 0) ssq[(size_t)row * 16 + u.pn * 4 + wc] = s; }
    }
};
template <class Epi, class Sched, bool ALIGN_EPI = false, bool SP2 = false>
__device__ __forceinline__ void gemm_phase(PG8_LAS unsigned char* lds, const Gemm g, const Sched& S, const Epi& E) {
    const int tid = threadIdx.x, wid = __builtin_amdgcn_readfirstlane(tid >> 6), lane = tid & 63, wr = wid >> 2, wc = wid & 3, fr = lane & 15, fq = lane >> 4;
    const int K = g.K, nt = K / BK;
    unsigned voffA[2], voffB[2];
#pragma unroll
    for (int i = 0; i < 2; ++i) { int R, C; stage_rc(tid * 16 + i * 8192, R, C); const int Rb = Epi::PERM ? ((R & ~31) + perm32(R & 31)) : R;
        voffA[i] = (unsigned)(R * K + C) * 2u; voffB[i] = (unsigned)(Rb * K + C) * 2u; }
    const size_t kstep = (size_t)(BK * 2);
    const size_t hstep = (size_t)HALF * K * 2;
    const size_t tstep = 2 * hstep;
    const unsigned ldsw = (unsigned)wid * 1024u;
    const int aoff = lds_byte(wr * 64 + fr, fq * 8), boff = lds_byte(wc * 32 + fr, fq * 8);
#define PG8_SA(b, h) (((b) * 2 + (h)) * HTB)
#define PG8_SB(b, h) ((4 + (b) * 2 + (h)) * HTB)
#define PG8_STAGE(bufoff, gbase, voff) do { _Pragma("unroll") for (int _i = 0; _i < 2; ++_i) \
        __builtin_amdgcn_global_load_lds((const unsigned*)((const char*)(gbase) + (voff)[_i]), (PG8_LAS unsigned*)(lds + (bufoff) + ldsw + _i * 8192), 16, 0, 0); } while (0)
#define PG8_LDA(dst, b, h) do { _Pragma("unroll") for (int m = 0; m < 4; ++m) _Pragma("unroll") for (int k = 0; k < 2; ++k) dst[m][k] = *(const PG8_LAS bf16x8*)(lds + PG8_SA(b, h) + aoff + m * 2048 + k * 1024); } while (0)
#define PG8_LDB(dst, b, h) do { _Pragma("unroll") for (int n = 0; n < 2; ++n) _Pragma("unroll") for (int k = 0; k < 2; ++k) dst[n][k] = *(const PG8_LAS bf16x8*)(lds + PG8_SB(b, h) + boff + n * 2048 + k * 1024); } while (0)
#define PG8_MMA(ai, bj, At, Bt) do { __builtin_amdgcn_s_setprio(1); _Pragma("unroll") for (int m = 0; m < 4; ++m) _Pragma("unroll") for (int n = 0; n < 2; ++n) _Pragma("unroll") for (int k = 0; k < 2; ++k) \
        acc[ai][bj][m][n] = __builtin_amdgcn_mfma_f32_16x16x32_bf16(Bt[n][k], At[m][k], acc[ai][bj][m][n], 0, 0, 0); __builtin_amdgcn_s_setprio(0); } while (0)
#define PG8_WAIT_V(n) asm volatile("s_waitcnt vmcnt(" #n ")" ::: "memory")
#define PG8_WAIT_L(n) asm volatile("s_waitcnt lgkmcnt(" #n ")" ::: "memory")
#define PG8_BAR __builtin_amdgcn_s_barrier()
#define PG8_SCHED __builtin_amdgcn_sched_barrier(0)
    Unit cur, nxt; int ui = 0;
    if (!S.next(0, cur)) return;
    f32x4 acc[2][2][4][2];
#pragma unroll
    for (int a = 0; a < 2; ++a)
#pragma unroll
        for (int b = 0; b < 2; ++b)
#pragma unroll
            for (int m = 0; m < 4; ++m)
#pragma unroll
                for (int n = 0; n < 2; ++n) acc[a][b][m][n] = (f32x4){0.f, 0.f, 0.f, 0.f};
    bf16x8 At[4][2], B0[2][2], B1[2][2];
    const char* cA = (const char*)g.A + (size_t)cur.pm * tstep; const char* cB = (const char*)g.Bt + (size_t)cur.pn * tstep;
    S.a_ready(cur);
    if constexpr (SP2) {
        PG8_STAGE(PG8_SB(0, 0), cB, voffB); PG8_STAGE(PG8_SB(0, 1), cB + hstep, voffB); PG8_STAGE(PG8_SA(0, 0), cA, voffA); PG8_STAGE(PG8_SA(0, 1), cA + hstep, voffA);
        if (wr == 1) PG8_BAR;
        PG8_WAIT_V(2); PG8_BAR;
        PG8_STAGE(PG8_SB(1, 0), cB + kstep, voffB); PG8_STAGE(PG8_SA(1, 0), cA + kstep, voffA); PG8_STAGE(PG8_SB(1, 1), cB + hstep + kstep, voffB);
        PG8_WAIT_V(6); PG8_BAR;
    } else {
        PG8_STAGE(PG8_SB(0, 0), cB, voffB); PG8_STAGE(PG8_SA(0, 0), cA, voffA); PG8_STAGE(PG8_SB(0, 1), cB + hstep, voffB); PG8_STAGE(PG8_SA(0, 1), cA + hstep, voffA);
        if (wr == 1) PG8_BAR;
        PG8_WAIT_V(4); PG8_BAR;
        PG8_STAGE(PG8_SB(1, 0), cB + kstep, voffB); PG8_STAGE(PG8_SA(1, 0), cA + kstep, voffA); PG8_STAGE(PG8_SB(1, 1), cB + hstep + kstep, voffB);
        PG8_WAIT_V(6); PG8_BAR;
    }
    for (;;) {
        const bool has_next = S.next(ui + 1, nxt);
        const char* nA = has_next ? (const char*)g.A + (size_t)nxt.pm * tstep : cA; const char* nB = has_next ? (const char*)g.Bt + (size_t)nxt.pn * tstep : cB;
        for (int t = 0; t < nt; t += 2) {
            const bool last = (t == nt - 2);
            const char* a1 = cA + (size_t)(t + 1) * kstep;
            const char* a2 = last ? nA : cA + (size_t)(t + 2) * kstep; const char* b2 = last ? nB : cB + (size_t)(t + 2) * kstep;
            const char* a3 = a2 + kstep; const char* b3 = b2 + kstep;
            if (last && has_next) S.a_ready(nxt);
            if constexpr (SP2) {
            PG8_LDB(B0, 0, 0); PG8_LDB(B1, 0, 1); PG8_SCHED; PG8_LDA(At, 0, 0); PG8_STAGE(PG8_SA(1, 1), a1 + hstep, voffA);
            PG8_WAIT_V(8); PG8_WAIT_L(0); PG8_BAR; PG8_MMA(0, 0, At, B0); PG8_MMA(0, 1, At, B1); PG8_BAR; PG8_SCHED;
            PG8_LDA(At, 0, 1); PG8_STAGE(PG8_SB(0, 0), b2, voffB); PG8_STAGE(PG8_SB(0, 1), b2 + hstep, voffB); PG8_STAGE(PG8_SA(0, 0), a2, voffA);
            PG8_WAIT_V(8); PG8_WAIT_L(0); PG8_BAR; PG8_MMA(1, 0, At, B0); PG8_MMA(1, 1, At, B1); PG8_BAR; PG8_SCHED;
            PG8_LDB(B0, 1, 0); PG8_LDB(B1, 1, 1); PG8_SCHED; PG8_LDA(At, 1, 0); PG8_STAGE(PG8_SA(0, 1), a2 + hstep, voffA);
            PG8_WAIT_V(8); PG8_WAIT_L(0); PG8_BAR; PG8_MMA(0, 0, At, B0); PG8_MMA(0, 1, At, B1); PG8_BAR; PG8_SCHED;
            PG8_LDA(At, 1, 1); PG8_STAGE(PG8_SB(1, 0), b3, voffB); PG8_STAGE(PG8_SB(1, 1), b3 + hstep, voffB); PG8_STAGE(PG8_SA(1, 0), a3, voffA);
            PG8_WAIT_V(8); PG8_WAIT_L(0); PG8_BAR; PG8_MMA(1, 0, At, B0); PG8_MMA(1, 1, At, B1); PG8_BAR; PG8_SCHED;
            } else {
            PG8_LDB(B0, 0, 0); PG8_SCHED; PG8_LDA(At, 0, 0); PG8_STAGE(PG8_SA(1, 1), a1 + hstep, voffA);
            PG8_WAIT_L(8); PG8_BAR; PG8_WAIT_L(0); PG8_MMA(0, 0, At, B0); PG8_BAR; PG8_SCHED;
            PG8_LDB(B1, 0, 1); PG8_STAGE(PG8_SB(0, 0), b2, voffB);
            PG8_BAR; PG8_WAIT_L(0); PG8_MMA(0, 1, At, B1); PG8_BAR;
            PG8_LDA(At, 0, 1); PG8_STAGE(PG8_SA(0, 0), a2, voffA);
            PG8_BAR; PG8_WAIT_L(0); PG8_MMA(1, 0, At, B0); PG8_BAR; PG8_SCHED;
            PG8_STAGE(PG8_SB(0, 1), b2 + hstep, voffB);
            PG8_WAIT_V(6); PG8_BAR; PG8_MMA(1, 1, At, B1); PG8_BAR;
            PG8_LDB(B0, 1, 0); PG8_SCHED; PG8_LDA(At, 1, 0); PG8_STAGE(PG8_SA(0, 1), a2 + hstep, voffA);
            PG8_WAIT_L(8); PG8_BAR; PG8_WAIT_L(0); PG8_MMA(0, 0, At, B0); PG8_BAR; PG8_SCHED;
            PG8_LDB(B1, 1, 1); PG8_STAGE(PG8_SB(1, 0), b3, voffB);
            PG8_BAR; PG8_WAIT_L(0); PG8_MMA(0, 1, At, B1); PG8_BAR;
            PG8_LDA(At, 1, 1); PG8_STAGE(PG8_SA(1, 0), a3, voffA);
            PG8_BAR; PG8_WAIT_L(0); PG8_MMA(1, 0, At, B0); PG8_BAR; PG8_SCHED;
            PG8_STAGE(PG8_SB(1, 1), b3 + hstep, voffB);
            PG8_WAIT_V(6); PG8_BAR; PG8_MMA(1, 1, At, B1); PG8_BAR;
            }
        }
        if constexpr (ALIGN_EPI) { if (wr == 0) PG8_BAR; }
        if constexpr (!Epi::AFTER_DRAIN) { E(acc, cur, wr, wc, fr, fq); S.done(cur); }
        if (!has_next) break;
#pragma unroll
        for (int a = 0; a < 2; ++a)
#pragma unroll
            for (int b = 0; b < 2; ++b)
#pragma unroll
                for (int m = 0; m < 4; ++m)
#pragma unroll
                    for (int n = 0; n < 2; ++n) acc[a][b][m][n] = (f32x4){0.f, 0.f, 0.f, 0.f};
        cur = nxt; cA = nA; cB = nB; ++ui;
        if constexpr (ALIGN_EPI) { if (wr == 1) PG8_BAR; }
    }
    PG8_WAIT_V(0);
    if constexpr (!ALIGN_EPI) { if (wr == 0) PG8_BAR; }
    PG8_BAR;
    if constexpr (Epi::AFTER_DRAIN) { E.fused(acc, cur, wr, wc, fr, fq, lds, wid, lane); S.done(cur); }
#undef PG8_SA
#undef PG8_SB
#undef PG8_STAGE
#undef PG8_LDA
#undef PG8_LDB
#undef PG8_MMA
#undef PG8_WAIT_V
#undef PG8_WAIT_L
#undef PG8_BAR
#undef PG8_SCHED
}
}

#ifndef MK_N_LAUNCHES
#define MK_N_LAUNCHES 1
#endif
#ifndef REPMASK
#define REPMASK 0
#endif
#define REP(k) _Pragma("unroll") for (int rep_ = 0; rep_ < (((REPMASK) >> (k)) & 1) + 1; ++rep_)
#ifndef SKIPMASK
#define SKIPMASK 0
#endif
constexpr int NPH = 8;
constexpr int NB = 8, SEQ = 4096, DM = 1024, NMETA = 16, DIN = 3072, DRG = 512, DFF = 2816;
constexpr int MROWS = NB * SEQ;
constexpr float EPS = 1e-6f;
constexpr size_t MiB = 1u << 20;
constexpr size_t WS_WIN = 0, WS_WO = 6 * MiB, WS_WGU = 8 * MiB, WS_WD = 19 * MiB, WS_WG = 25 * MiB;
constexpr size_t WS_RGA = 26 * MiB, WS_RGH = 26 * MiB + 512 * 1024, WS_HM = 27 * MiB, WS_BT = 27 * MiB + 64 * 1024, WS_SM = 28 * MiB;
constexpr size_t WS_SSQ1 = 30 * MiB, WS_SSQ2 = 32 * MiB, WS_SL = 34 * MiB;
constexpr size_t WS_BAR = 50 * MiB;
constexpr int MISC_OFF = 131072 + 320;
constexpr size_t WS_XN = 64 * MiB;
constexpr size_t WS_Y = 128 * MiB;
constexpr size_t WS_P = 192 * MiB;
constexpr size_t WS_END = 392 * MiB;
constexpr int LDS_BYTES = 147456;

#define LAS __attribute__((address_space(3)))
typedef unsigned short bf16;
typedef float f32x4 __attribute__((ext_vector_type(4)));
typedef short bf16x8 __attribute__((ext_vector_type(8)));
typedef unsigned v4u __attribute__((ext_vector_type(4)));
typedef unsigned v2u __attribute__((ext_vector_type(2)));
__device__ __forceinline__ float bf2f(unsigned short b) { return __uint_as_float(((unsigned)b) << 16); }
__device__ __forceinline__ unsigned f2bf(float f) { unsigned u = __float_as_uint(f); return (u + 0x7fffu + ((u >> 16) & 1u)) >> 16; }
__device__ __forceinline__ unsigned pk2(float lo, float hi) { return f2bf(lo) | (f2bf(hi) << 16); }
__device__ __forceinline__ float sigm(float x) { return __builtin_amdgcn_rcpf(1.0f + __expf(-x)); }
__device__ __forceinline__ float wave_sum(float v) {
#pragma unroll
    for (int o = 1; o < 64; o <<= 1) v += __shfl_xor(v, o);
    return v;
}
#define MFMA16(a, b, c) __builtin_amdgcn_mfma_f32_16x16x32_bf16((a), (b), (c), 0, 0, 0)

__device__ __forceinline__ void p0_transpose_item(const float* W, int K, int N, bf16* WT, LAS float* scr, int item, int lane, int mode, const float* ksc) {
    const int nblk = N / 32, kb = item / nblk, nb = item % nblk, k0 = 64 * kb, n0 = 32 * nb;
    int src0 = n0;
    if (mode == 1) { const int t = n0 >> 8, c = n0 & 255; src0 = (c < 128) ? (t * 128 + c) : (DFF + t * 128 + (c - 128)); }
#pragma unroll 8
    for (int i = 0; i < 32; ++i) { const int kk = 2 * i + (lane >> 5); float v = W[(size_t)(k0 + kk) * N + src0 + (lane & 31)]; if (mode == 1) v *= ksc[k0 + kk]; scr[kk * 33 + (lane & 31)] = v; }
    asm volatile("s_waitcnt lgkmcnt(0)" ::: "memory");
    const int c = lane & 7;
#pragma unroll
    for (int j = 0; j < 4; ++j) { const int n = (lane >> 3) + 8 * j; const LAS float* s = scr + (8 * c) * 33 + n;
        v4u o; o.x = pk2(s[0 * 33], s[1 * 33]); o.y = pk2(s[2 * 33], s[3 * 33]); o.z = pk2(s[4 * 33], s[5 * 33]); o.w = pk2(s[6 * 33], s[7 * 33]);
        *(v4u*)(WT + (size_t)(n0 + n) * K + k0 + 8 * c) = o; }
    asm volatile("s_waitcnt lgkmcnt(0)" ::: "memory");
}
__device__ __forceinline__ void rms_rows2_to_bf16(const float* xrow, const float* g, bf16* orow, int lane) {
    const f32x4* xr = (const f32x4*)xrow + lane; const f32x4* gr = (const f32x4*)g + lane;
    f32x4 v[2][4]; float s[2] = {0.f, 0.f};
#pragma unroll
    for (int r = 0; r < 2; ++r)
#pragma unroll
        for (int j = 0; j < 4; ++j) v[r][j] = xr[256 * r + 64 * j];
#pragma unroll
    for (int r = 0; r < 2; ++r)
#pragma unroll
        for (int j = 0; j < 4; ++j) s[r] += (v[r][j].x * v[r][j].x + v[r][j].y * v[r][j].y) + (v[r][j].z * v[r][j].z + v[r][j].w * v[r][j].w);
    const float rinv[2] = {rsqrtf(wave_sum(s[0]) * (1.f / DM) + EPS), rsqrtf(wave_sum(s[1]) * (1.f / DM) + EPS)};
    unsigned long long* o8 = (unsigned long long*)orow + lane;
#pragma unroll
    for (int j = 0; j < 4; ++j) { const f32x4 gg = gr[64 * j];
#pragma unroll
        for (int r = 0; r < 2; ++r)
            o8[256 * r + 64 * j] = (unsigned long long)pk2(v[r][j].x * rinv[r] * gg.x, v[r][j].y * rinv[r] * gg.y) | ((unsigned long long)pk2(v[r][j].z * rinv[r] * gg.z, v[r][j].w * rinv[r] * gg.w) << 32); }
}

constexpr int RG_WAVE_LDS = 10496;
__device__ __forceinline__ float bflo(unsigned u) { return __uint_as_float(u << 16); }
__device__ __forceinline__ float bfhi(unsigned u) { return __uint_as_float(u & 0xffff0000u); }
__device__ __forceinline__ unsigned cvtpk(float lo, float hi) { unsigned r; asm volatile("v_cvt_pk_bf16_f32 %0, %1, %2" : "=v"(r) : "v"(lo), "v"(hi)); return r; }
__device__ __forceinline__ void rg_scan(LAS unsigned char* lds, const bf16* P, const bf16* Wg, const float* conv_w, const float* conv_b, const float* b_r, const float* b_i, const float* lam,
                                        float* Aseg, float* Hseg, float* hmeta, bf16* HLOC, bf16* PAC, int b, int seg, bool is_meta, int wave, int lane) {
    const int c = wave * 64 + lane;
    LAS bf16* xcb = (LAS bf16*)(lds + wave * RG_WAVE_LDS);
    LAS float* pre_r = (LAS float*)(lds + wave * RG_WAVE_LDS + 2304);
    LAS float* pre_i = pre_r + 1024;
    const float cw0 = conv_w[c], cw1 = conv_w[DRG + c], cw2 = conv_w[2 * DRG + c], cw3 = conv_w[3 * DRG + c], cb = conv_b[c];
    const float br = b_r[c], bi = b_i[c];
    const float sp = 8.0f * log1pf(__expf(-lam[c]));
    bf16x8 bw[2][4][2];
#pragma unroll
    for (int g = 0; g < 2; ++g)
#pragma unroll
        for (int nt = 0; nt < 4; ++nt)
#pragma unroll
            for (int ks = 0; ks < 2; ++ks) bw[g][nt][ks] = *(const bf16x8*)(Wg + ((size_t)(g * 8 + wave) * 64 + nt * 16 + (lane & 15)) * 64 + ks * 32 + (lane >> 4) * 8);
    float h = 0.f, pa = 1.f, xm3 = 0.f, xm2 = 0.f, xm1 = 0.f;
    const int nsb = is_meta ? 1 : 8;
    const size_t row0 = is_meta ? (size_t)MROWS : (size_t)b * SEQ + (size_t)seg * 128;
    if (!is_meta) {
        const size_t r3 = (seg == 0) ? (size_t)MROWS + 13 : row0 - 3;
        xm3 = bf2f(P[r3 * DIN + c]); xm2 = bf2f(P[(r3 + 1) * DIN + c]); xm1 = bf2f(P[(r3 + 2) * DIN + c]);
    }
    for (int sb = 0; sb < nsb; ++sb) {
        const size_t rb = row0 + (size_t)sb * 16;
        float e[19], xc[16];
        e[0] = xm3; e[1] = xm2; e[2] = xm1;
#pragma unroll
        for (int i = 0; i < 16; ++i) e[3 + i] = bf2f(P[(rb + i) * DIN + c]);
        xm3 = e[16]; xm2 = e[17]; xm1 = e[18];
#pragma unroll
        for (int i = 0; i < 16; i += 2) { xc[i] = cb + cw0 * e[i] + cw1 * e[i + 1] + cw2 * e[i + 2] + cw3 * e[i + 3]; xc[i + 1] = cb + cw0 * e[i + 1] + cw1 * e[i + 2] + cw2 * e[i + 3] + cw3 * e[i + 4];
            const unsigned pk = cvtpk(xc[i], xc[i + 1]); xcb[i * 72 + lane] = (bf16)(pk & 0xffffu); xcb[(i + 1) * 72 + lane] = (bf16)(pk >> 16); }
        asm volatile("s_waitcnt lgkmcnt(0)" ::: "memory"); __builtin_amdgcn_wave_barrier();
        bf16x8 af[2];
#pragma unroll
        for (int ks = 0; ks < 2; ++ks) af[ks] = *(const LAS bf16x8*)(xcb + (lane & 15) * 72 + ks * 32 + (lane >> 4) * 8);
#pragma unroll
        for (int g = 0; g < 2; ++g)
#pragma unroll
            for (int nt = 0; nt < 4; ++nt) { f32x4 acc = {0.f, 0.f, 0.f, 0.f};
#pragma unroll
                for (int ks = 0; ks < 2; ++ks) acc = MFMA16(af[ks], bw[g][nt][ks], acc);
                LAS float* pre = g ? pre_i : pre_r;
#pragma unroll
                for (int j = 0; j < 4; ++j) pre[((lane >> 4) * 4 + j) * 64 + nt * 16 + (lane & 15)] = acc[j]; }
        asm volatile("s_waitcnt lgkmcnt(0)" ::: "memory"); __builtin_amdgcn_wave_barrier();
        float hv[16], pv[16];
#pragma unroll
        for (int i = 0; i < 16; ++i) {
            const float r = sigm(pre_r[i * 64 + lane] + br), ig = sigm(pre_i[i * 64 + lane] + bi);
            const float la = -sp * r, a = __expf(la), x2 = 2.0f * la;
            const float poly = -x2 * (1.0f + x2 * 0.5f * (1.0f + x2 * (1.0f / 3.0f) * (1.0f + x2 * 0.25f * (1.0f + x2 * 0.2f * (1.0f + x2 * (1.0f / 6.0f))))));
            const float om = (x2 > -0.25f) ? poly : (1.0f - a * a);
            h = a * h + __builtin_amdgcn_sqrtf(om) * (ig * xc[i]); pa *= a; hv[i] = h; pv[i] = pa;
        }
        asm volatile("s_waitcnt lgkmcnt(0)" ::: "memory"); __builtin_amdgcn_wave_barrier();
        if (!is_meta) {
#pragma unroll
            for (int i = 0; i < 16; i += 2) { const unsigned hp = cvtpk(hv[i], hv[i + 1]), pp = cvtpk(pv[i], pv[i + 1]);
                HLOC[(rb + i) * DRG + c] = (bf16)(hp & 0xffffu); HLOC[(rb + i + 1) * DRG + c] = (bf16)(hp >> 16);
                PAC[(rb + i) * DRG + c] = (bf16)(pp & 0xffffu); PAC[(rb + i + 1) * DRG + c] = (bf16)(pp >> 16); }
        }
    }
    if (is_meta) hmeta[c] = h; else { Aseg[(size_t)(b * 32 + seg) * DRG + c] = pa; Hseg[(size_t)(b * 32 + seg) * DRG + c] = h; }
}
__device__ __forceinline__ void rg_final(LAS unsigned char* lds, const bf16* P, const bf16* HLOC, const bf16* PAC, const float* Aseg, const float* Hseg, const float* hmeta, const float* gnorm, bf16* Y,
                                         int b, int seg, int tid, int wave, int lane) {
    LAS float* hin = (LAS float*)lds;
    { float h = hmeta[tid]; const float* ap = Aseg + (size_t)b * 32 * DRG + tid; const float* hp = Hseg + (size_t)b * 32 * DRG + tid;
#pragma unroll 8
      for (int j = 0; j < seg; ++j) h = ap[(size_t)j * DRG] * h + hp[(size_t)j * DRG];
      hin[tid] = h; }
    __syncthreads();
    const f32x4 h0 = *(const LAS f32x4*)(hin + 8 * lane), h1 = *(const LAS f32x4*)(hin + 8 * lane + 4);
    const f32x4 g0 = *(const f32x4*)(gnorm + 8 * lane), g1 = *(const f32x4*)(gnorm + 8 * lane + 4);
    const float hi8[8] = {h0.x, h0.y, h0.z, h0.w, h1.x, h1.y, h1.z, h1.w}, gn8[8] = {g0.x, g0.y, g0.z, g0.w, g1.x, g1.y, g1.z, g1.w};
#pragma unroll 4
    for (int i = 0; i < 16; ++i) { const size_t row = (size_t)b * SEQ + (size_t)seg * 128 + wave * 16 + i;
        const v4u hl = *(const v4u*)(HLOC + row * DRG + 8 * lane), pc = *(const v4u*)(PAC + row * DRG + 8 * lane), gv = *(const v4u*)(P + row * DIN + DRG + 8 * lane);
        float y[8]; float s = 0.f;
#pragma unroll
        for (int q = 0; q < 4; ++q) { const float hA = bflo(hl[q]) + bflo(pc[q]) * hi8[2 * q], hB = bfhi(hl[q]) + bfhi(pc[q]) * hi8[2 * q + 1]; const float gA = bflo(gv[q]), gB = bfhi(gv[q]);
            y[2 * q] = gA * sigm(1.5957691216f * (gA + 0.044715f * gA * gA * gA)) * hA; y[2 * q + 1] = gB * sigm(1.5957691216f * (gB + 0.044715f * gB * gB * gB)) * hB;
            s += y[2 * q] * y[2 * q] + y[2 * q + 1] * y[2 * q + 1]; }
        const float rinv = rsqrtf(wave_sum(s) * (1.0f / DRG) + EPS);
        v4u o;
#pragma unroll
        for (int q = 0; q < 4; ++q) o[q] = cvtpk(y[2 * q] * rinv * gn8[2 * q], y[2 * q + 1] * rinv * gn8[2 * q + 1]);
        *(v4u*)(Y + row * DM + 8 * lane) = o; }
}

constexpr int HG_QT = 0, HG_KH = 17408, HG_KHT = 34816, HG_VT = 53248, HG_ST = 71680, HG_AM = 106496, HG_GS = 115712, HG_EB = 119808, HG_SQ = 120320;
template <bool FINAL>
__device__ __forceinline__ void hg_run(LAS unsigned char* lds, const bf16* P, const float* Lb, const float* gnorm, float* Sloc, float* Btot, float* Smeta, bf16* Y,
                                       int b, int h, int sc, bool is_meta, int tid, int wave, int lane) {
    LAS bf16* Qt = (LAS bf16*)(lds + HG_QT); LAS bf16* Kh = (LAS bf16*)(lds + HG_KH); LAS bf16* KhT = (LAS bf16*)(lds + HG_KHT); LAS bf16* VT = (LAS bf16*)(lds + HG_VT);
    LAS bf16* St = (LAS bf16*)(lds + HG_ST); LAS bf16* Am = (LAS bf16*)(lds + HG_AM); LAS float* gpr = (LAS float*)(lds + HG_GS); LAS float* eb = (LAS float*)(lds + HG_EB); LAS float* ssqp = (LAS float*)(lds + HG_SQ);
    typedef float f32x2 __attribute__((ext_vector_type(2)));
    const int g = wave, k0 = 2 * lane, lr = lane & 15, lq = lane >> 4;
    const float lb0 = __builtin_amdgcn_rcpf(1.0f + __expf(Lb[DRG + h * 128 + k0] - Lb[h * 128 + k0]));
    const float lb1 = __builtin_amdgcn_rcpf(1.0f + __expf(Lb[DRG + h * 128 + k0 + 1] - Lb[h * 128 + k0 + 1]));
    const int item = (b * 4 + h) * 8 + sc;
    const int tt = wave & 3, vh = wave >> 2;
    f32x4 S[8];
#pragma unroll
    for (int tv = 0; tv < 8; ++tv) S[tv] = (f32x4){0.f, 0.f, 0.f, 0.f};
    float gnv[4] = {0.f, 0.f, 0.f, 0.f};
    if (FINAL) {
#pragma unroll
        for (int q = 0; q < 4; ++q) gnv[q] = gnorm[16 * (4 * vh + q) + lr];
#pragma unroll
        for (int tv = 0; tv < 8; ++tv) S[tv] = *(const f32x4*)(Smeta + (size_t)h * 16384 + ((wave * 8 + tv) * 64 + lane) * 4);
        for (int jj = 0; jj < sc; ++jj) { const int it = (b * 4 + h) * 8 + jj;
            const f32x4 d4 = *(const f32x4*)(Btot + (size_t)it * 128 + 16 * wave + 4 * lq); const f32x4 d = {__expf(d4.x), __expf(d4.y), __expf(d4.z), __expf(d4.w)};
#pragma unroll
            for (int tv = 0; tv < 8; ++tv) { const f32x4 L = *(const f32x4*)(Sloc + (size_t)it * 16384 + ((wave * 8 + tv) * 64 + lane) * 4); S[tv] = d * S[tv] + L; } }
#pragma unroll
        for (int tv = 0; tv < 8; ++tv) { v2u w; w.x = cvtpk(S[tv][0], S[tv][1]); w.y = cvtpk(S[tv][2], S[tv][3]); *(LAS v2u*)(St + (16 * tv + lr) * 136 + 16 * wave + 4 * lq) = w; }
    }
    float btot0 = 0.f, btot1 = 0.f;
    const int nch = is_meta ? 1 : 8, nvalid = is_meta ? NMETA : 64;
    const size_t rowbase0 = is_meta ? (size_t)MROWS : (size_t)b * SEQ + (size_t)sc * 512;
    unsigned rf[8], ri[8], rq[8];
#define HG_LOAD(rb_) do { _Pragma("unroll") for (int i = 0; i < 8; ++i) { const bool valid = (8 * g + i) < nvalid; const bf16* pr = P + ((rb_) + (valid ? 8 * g + i : 0)) * DIN + h * 128 + k0; \
        rf[i] = *(const unsigned*)(pr + 1536); ri[i] = valid ? *(const unsigned*)(pr + 2048) : 0u; if (FINAL) rq[i] = *(const unsigned*)(pr + 1024); } } while (0)
    HG_LOAD(rowbase0);
    for (int ch = 0; ch < nch; ++ch) {
        const size_t rowbase = rowbase0 + (size_t)ch * 64;
        unsigned short hgr[16];
        if (FINAL) {
#pragma unroll
            for (int j = 0; j < 4; ++j)
#pragma unroll
                for (int q = 0; q < 4; ++q) hgr[j * 4 + q] = P[(rowbase + 16 * tt + 4 * lq + j) * DIN + 2560 + h * 128 + 16 * (4 * vh + q) + lr];
        }
        float cpA[8], cpB[8], kA[8], kB[8], qA[8], qB[8]; float ca = 1.f, cb = 1.f;
#pragma unroll
        for (int i = 0; i < 8; ++i) { const bool valid = (8 * g + i) < nvalid;
            float fa = lb0 + (1.0f - lb0) * sigm(bflo(rf[i])), fb = lb1 + (1.0f - lb1) * sigm(bfhi(rf[i]));
            fa = valid ? fa : 1.0f; fb = valid ? fb : 1.0f;
            ca *= fa; cb *= fb; cpA[i] = ca; cpB[i] = cb; kA[i] = 1.0f - fa; kB[i] = 1.0f - fb;
            if (FINAL) { const float q0 = bflo(rq[i]), q1 = bfhi(rq[i]); qA[i] = q0 * sigm(q0); qB[i] = q1 * sigm(q1); } }
        *(LAS f32x2*)(gpr + g * 128 + k0) = (f32x2){ca, cb};
        __syncthreads();
        float pa = 1.f, pb = 1.f, tota = 1.f, totb = 1.f;
#pragma unroll
        for (int gg = 0; gg < 8; ++gg) { const f32x2 v = *(const LAS f32x2*)(gpr + gg * 128 + k0); tota *= v.x; totb *= v.y; pa *= (gg < g) ? v.x : 1.0f; pb *= (gg < g) ? v.y : 1.0f; }
        unsigned kpA[4], kpB[4], vpA[4], vpB[4];
#pragma unroll
        for (int i = 0; i < 8; i += 2) { const float ca0 = pa * cpA[i], ca1 = pa * cpA[i + 1], cb0 = pb * cpB[i], cb1 = pb * cpB[i + 1];
            const unsigned ka = cvtpk(kA[i] * __builtin_amdgcn_rcpf(ca0), kA[i + 1] * __builtin_amdgcn_rcpf(ca1)), kb = cvtpk(kB[i] * __builtin_amdgcn_rcpf(cb0), kB[i + 1] * __builtin_amdgcn_rcpf(cb1));
            kpA[i >> 1] = ka; kpB[i >> 1] = kb;
            vpA[i >> 1] = (ri[i] & 0xffffu) | (ri[i + 1] << 16); vpB[i >> 1] = (ri[i] >> 16) | (ri[i + 1] & 0xffff0000u);
            if (FINAL) { *(LAS unsigned*)(Kh + (8 * g + i) * 136 + k0) = (ka & 0xffffu) | (kb << 16); *(LAS unsigned*)(Kh + (8 * g + i + 1) * 136 + k0) = (ka >> 16) | (kb & 0xffff0000u);
                *(LAS unsigned*)(Qt + (8 * g + i) * 136 + k0) = cvtpk(qA[i] * ca0, qB[i] * cb0); *(LAS unsigned*)(Qt + (8 * g + i + 1) * 136 + k0) = cvtpk(qA[i + 1] * ca1, qB[i + 1] * cb1); } }
        *(LAS v4u*)(KhT + k0 * 72 + 8 * g) = (v4u){kpA[0], kpA[1], kpA[2], kpA[3]}; *(LAS v4u*)(KhT + (k0 + 1) * 72 + 8 * g) = (v4u){kpB[0], kpB[1], kpB[2], kpB[3]};
        *(LAS v4u*)(VT + k0 * 72 + 8 * g) = (v4u){vpA[0], vpA[1], vpA[2], vpA[3]}; *(LAS v4u*)(VT + (k0 + 1) * 72 + 8 * g) = (v4u){vpB[0], vpB[1], vpB[2], vpB[3]};
        if (g == 0) *(LAS f32x2*)(eb + k0) = (f32x2){tota, totb};
        if (!FINAL) { btot0 += __logf(tota); btot1 += __logf(totb); }
        __syncthreads();
        if (ch + 1 < nch) HG_LOAD(rowbase + 64);
        if (FINAL) {
            { const int ta = wave >> 1;
#pragma unroll
              for (int q = 0; q < 2; ++q) { const int ts = 2 * (wave & 1) + q; f32x4 acc = {0.f, 0.f, 0.f, 0.f};
#pragma unroll
                for (int ks = 0; ks < 4; ++ks) { const bf16x8 a = *(const LAS bf16x8*)(Qt + (16 * ta + lr) * 136 + ks * 32 + lq * 8); const bf16x8 bb = *(const LAS bf16x8*)(Kh + (16 * ts + lr) * 136 + ks * 32 + lq * 8); acc = MFMA16(a, bb, acc); }
#pragma unroll
                for (int j = 0; j < 4; ++j) { const int t = 16 * ta + 4 * lq + j, s = 16 * ts + lr; Am[t * 72 + s] = (bf16)f2bf((s <= t) ? acc[j] : 0.f); } } }
            __syncthreads();
            f32x4 o[4];
#pragma unroll
            for (int q = 0; q < 4; ++q) o[q] = (f32x4){0.f, 0.f, 0.f, 0.f};
#pragma unroll
            for (int ks = 0; ks < 4; ++ks) { const bf16x8 a = *(const LAS bf16x8*)(Qt + (16 * tt + lr) * 136 + ks * 32 + lq * 8);
#pragma unroll
                for (int q = 0; q < 4; ++q) { const bf16x8 bb = *(const LAS bf16x8*)(St + (16 * (4 * vh + q) + lr) * 136 + ks * 32 + lq * 8); o[q] = MFMA16(a, bb, o[q]); } }
#pragma unroll
            for (int ks = 0; ks < 2; ++ks) { const bf16x8 a = *(const LAS bf16x8*)(Am + (16 * tt + lr) * 72 + ks * 32 + lq * 8);
#pragma unroll
                for (int q = 0; q < 4; ++q) { const bf16x8 bb = *(const LAS bf16x8*)(VT + (16 * (4 * vh + q) + lr) * 72 + ks * 32 + lq * 8); o[q] = MFMA16(a, bb, o[q]); } }
#pragma unroll
            for (int j = 0; j < 4; ++j) { float p = (o[0][j] * o[0][j] + o[1][j] * o[1][j]) + (o[2][j] * o[2][j] + o[3][j] * o[3][j]);
                p += __shfl_xor(p, 1); p += __shfl_xor(p, 2); p += __shfl_xor(p, 4); p += __shfl_xor(p, 8);
                if (lr == 0) ssqp[vh * 64 + 16 * tt + 4 * lq + j] = p; }
            __syncthreads();
#pragma unroll
            for (int j = 0; j < 4; ++j) { const int t = 16 * tt + 4 * lq + j; const float rinv = rsqrtf((ssqp[t] + ssqp[64 + t]) * (1.0f / 128.0f) + EPS); const size_t row = rowbase + t;
#pragma unroll
                for (int q = 0; q < 4; ++q) { const int v = 16 * (4 * vh + q) + lr; const float hgv = bf2f(hgr[j * 4 + q]);
                    Y[row * DM + DRG + h * 128 + v] = (bf16)f2bf(o[q][j] * rinv * gnv[q] * (hgv * sigm(hgv))); } }
        }
#pragma unroll
        for (int ks = 0; ks < 2; ++ks) { const bf16x8 a = *(const LAS bf16x8*)(KhT + (16 * wave + lr) * 72 + ks * 32 + lq * 8);
#pragma unroll
            for (int tv = 0; tv < 8; ++tv) { const bf16x8 bb = *(const LAS bf16x8*)(VT + (16 * tv + lr) * 72 + ks * 32 + lq * 8); S[tv] = MFMA16(a, bb, S[tv]); } }
        { const f32x4 e4 = *(const LAS f32x4*)(eb + 16 * wave + 4 * lq);
#pragma unroll
          for (int tv = 0; tv < 8; ++tv) S[tv] = S[tv] * e4; }
        if (FINAL) {
#pragma unroll
            for (int tv = 0; tv < 8; ++tv) { v2u w; w.x = cvtpk(S[tv][0], S[tv][1]); w.y = cvtpk(S[tv][2], S[tv][3]); *(LAS v2u*)(St + (16 * tv + lr) * 136 + 16 * wave + 4 * lq) = w; }
        }
    }
#undef HG_LOAD
    if (!FINAL) {
        float* dst = is_meta ? (Smeta + (size_t)h * 16384) : (Sloc + (size_t)item * 16384);
#pragma unroll
        for (int tv = 0; tv < 8; ++tv) *(f32x4*)(dst + ((wave * 8 + tv) * 64 + lane) * 4) = S[tv];
        if (!is_meta && g == 0) *(f32x2*)(Btot + (size_t)item * 128 + k0) = (f32x2){btot0, btot1};
    }
}

#define XB_TMO      128
#define XB_XCNT(j)  (256  + 64 * (j))
#define XB_XSUB(j)  (1280 + 64 * (j))
#define XB_XGEN(j)  (2304 + 64 * (j))
#define XB_TOP      3328
#define XB_TOPGEN   3392
#define XCD_BAR_WORDS 3456
#define XB_SPIN_CAP (1u << 18)

__device__ __forceinline__ unsigned xb_ld(unsigned* p)              { return __hip_atomic_load(p, __ATOMIC_RELAXED, __HIP_MEMORY_SCOPE_AGENT); }
__device__ __forceinline__ unsigned xb_add(unsigned* p, unsigned v) { return __hip_atomic_fetch_add(p, v, __ATOMIC_RELAXED, __HIP_MEMORY_SCOPE_AGENT); }
__device__ __forceinline__ unsigned xb_xcc_id() { return (unsigned)__builtin_amdgcn_s_getreg((3 << 11) | 20) & 0xFu; }
#define XB_SPIN(cond, bar) do { unsigned _sp = 0; while (cond) { __builtin_amdgcn_s_sleep(1); \
    if ((++_sp & 255u) == 0u) { if (xb_ld(&(bar)[XB_TMO])) break; if (_sp > XB_SPIN_CAP) { atomicAdd(&(bar)[XB_TMO], 1u); break; } } } } while (0)

struct XcdBarrier {
    unsigned* bar; unsigned x;
    volatile LAS unsigned* st;
};

__device__ __forceinline__ XcdBarrier xcd_barrier_post(unsigned* bar, volatile LAS unsigned* st) {
    XcdBarrier b; b.bar = bar; b.x = xb_xcc_id(); b.st = st;
    if (threadIdx.x == 0) (void)xb_add(&bar[XB_XCNT(b.x)], 1u);
    return b;
}
__device__ __forceinline__ void xcd_barrier_complete(unsigned* bar, unsigned x, unsigned& nloc, unsigned& nx) {
    const unsigned G = gridDim.x * gridDim.y * gridDim.z;
    unsigned sum, cnt, mine, sp = 0u;
    for (;;) {
        sum = 0u; cnt = 0u; mine = 0u;
#pragma unroll
        for (unsigned j = 0; j < 16; ++j) { const unsigned c = xb_ld(&bar[XB_XCNT(j)]); sum += c; cnt += (c > 0u) ? 1u : 0u; mine = (j == x) ? c : mine; }
        if (sum == G) break;
        __builtin_amdgcn_s_sleep(1);
        if ((++sp & 255u) == 0u) { if (xb_ld(&bar[XB_TMO])) break; if (sp > XB_SPIN_CAP) { atomicAdd(&bar[XB_TMO], 1u); break; } }
    }
    nloc = mine > 0u ? mine : 1u; nx = cnt > 0u ? cnt : 1u;
}

__device__ __forceinline__ void xcd_barrier(const XcdBarrier& b) {
    asm volatile("s_waitcnt vmcnt(0)" ::: "memory");
    __syncthreads();
    if (threadIdx.x == 0) {
        unsigned* bar = b.bar;
        __builtin_amdgcn_s_waitcnt(0);
        unsigned nloc = b.st[0], nx = b.st[1];
        if (nloc == 0u) { xcd_barrier_complete(bar, b.x, nloc, nx); b.st[0] = nloc; b.st[1] = nx; }
        const unsigned old = xb_add(&bar[XB_XSUB(b.x)], 1u);
        const unsigned gen = old / nloc;
        if (old + 1u == (gen + 1u) * nloc) {
            __builtin_amdgcn_fence(__ATOMIC_RELEASE, "agent");
            asm volatile("s_waitcnt vmcnt(0)" ::: "memory");
            const unsigned og = xb_add(&bar[XB_TOP], 1u);
            const unsigned tg = og / nx;
            if (og + 1u == (tg + 1u) * nx) xb_add(&bar[XB_TOPGEN], 1u);
            else XB_SPIN(xb_ld(&bar[XB_TOPGEN]) == tg, bar);
            __builtin_amdgcn_fence(__ATOMIC_ACQUIRE, "agent");
            xb_add(&bar[XB_XGEN(b.x)], 1u);
            asm volatile("s_waitcnt vmcnt(0)" ::: "memory");
        } else {
            XB_SPIN(xb_ld(&bar[XB_XGEN(b.x)]) == gen, bar);
            __builtin_amdgcn_fence(__ATOMIC_ACQUIRE, "agent");
            asm volatile("s_waitcnt vmcnt(0)" ::: "memory");
        }
    }
    __syncthreads();
}

struct Args { const float* in[19]; float* out; unsigned char* ws; int ph_lo, ph_hi; };
__global__ void __launch_bounds__(512, 2) fwd_megakernel(Args args) {
    extern __shared__ __attribute__((aligned(16))) unsigned char lds_raw[];
    LAS unsigned char* lds = (LAS unsigned char*)lds_raw;
    cg::grid_group grid = cg::this_grid();
    const int tid = threadIdx.x, lane = tid & 63, wave = __builtin_amdgcn_readfirstlane(tid >> 6);
    const int G = gridDim.x, bx = blockIdx.x;
    unsigned char* ws = args.ws;
    const float* x = args.in[0]; const float* meta = args.in[1]; const float* mix_g = args.in[2]; const float* w_in = args.in[3];
    const float* conv_w = args.in[4]; const float* conv_b = args.in[5]; const float* w_rg = args.in[6]; const float* b_rg = args.in[7];
    const float* w_ig = args.in[8]; const float* b_ig = args.in[9]; const float* lam = args.in[10]; const float* rg_g = args.in[11];
    const float* hg_lb = args.in[12]; const float* hg_g = args.in[13]; const float* w_out = args.in[14]; const float* ffn_g = args.in[15];
    const float* w_gu = args.in[16]; const float* w_down = args.in[17]; const float* fin_g = args.in[18];
    bf16* Win_t = (bf16*)(ws + WS_WIN); bf16* Wo_t = (bf16*)(ws + WS_WO); bf16* Wgu_t = (bf16*)(ws + WS_WGU); bf16* Wd_t = (bf16*)(ws + WS_WD); bf16* Wg_t = (bf16*)(ws + WS_WG);
    float* Aseg = (float*)(ws + WS_RGA); float* Hseg = (float*)(ws + WS_RGH); float* hmeta = (float*)(ws + WS_HM); float* Btot = (float*)(ws + WS_BT); float* Smeta = (float*)(ws + WS_SM);
    float* SSQ1 = (float*)(ws + WS_SSQ1); float* SSQ2 = (float*)(ws + WS_SSQ2); float* Sloc = (float*)(ws + WS_SL);
    bf16* XN = (bf16*)(ws + WS_XN); bf16* H1B = (bf16*)(ws + WS_XN); bf16* HLOC = (bf16*)(ws + WS_XN); bf16* PAC = (bf16*)(ws + WS_XN + 32 * MiB); bf16* Y = (bf16*)(ws + WS_Y); bf16* P = (bf16*)(ws + WS_P); bf16* ACT = (bf16*)(ws + WS_P);
    float* out = args.out;
    const int lo = args.ph_lo, hi = args.ph_hi;
    volatile LAS unsigned* misc = (volatile LAS unsigned*)(lds + MISC_OFF);
    if (tid < 2) misc[tid] = 0u;
    __syncthreads();
    (void)xcd_barrier_post((unsigned*)(ws + WS_BAR), misc);
    if (hi > 1000) grid.sync();
#define IN(k) (lo <= (k) && (k) < hi)
#define GBAR() do { XcdBarrier b_; b_.bar = (unsigned*)(args.ws + WS_BAR); b_.x = xb_xcc_id(); b_.st = (volatile LAS unsigned*)(lds + MISC_OFF); xcd_barrier(b_); } while (0)
#define SEAM(k) do { if (IN(k) && IN((k) + 1)) GBAR(); } while (0)

    REP(0) if (IN(0) && !(SKIPMASK & 1)) { if (rep_) GBAR();
        const bool split = G > 48;
        const int gw = split ? (bx - 24) * 8 + wave : bx * 8 + wave, NGW = split ? (G - 24) * 8 : G * 8;
        if (bx < 24) {
            LAS float* um = (LAS float*)lds;
            LAS float* red = (LAS float*)(lds + 65536);
#pragma unroll
            for (int r = 0; r < 2; ++r) { const int m = wave * 2 + r; const f32x4* xr = (const f32x4*)(meta + (size_t)m * DM) + lane; const f32x4* gr = (const f32x4*)mix_g + lane;
                f32x4 v[4]; float s = 0.f;
#pragma unroll
                for (int j = 0; j < 4; ++j) { v[j] = xr[64 * j]; s += (v[j].x * v[j].x + v[j].y * v[j].y) + (v[j].z * v[j].z + v[j].w * v[j].w); }
                const float rinv = rsqrtf(wave_sum(s) * (1.f / DM) + EPS);
#pragma unroll
                for (int j = 0; j < 4; ++j) { const f32x4 gg = gr[64 * j]; const int k0 = 256 * j + 4 * lane;
                    um[(k0 + 0) * 16 + m] = v[j].x * rinv * gg.x; um[(k0 + 1) * 16 + m] = v[j].y * rinv * gg.y; um[(k0 + 2) * 16 + m] = v[j].z * rinv * gg.z; um[(k0 + 3) * 16 + m] = v[j].w * rinv * gg.w; } }
            __syncthreads();
            const int kg = tid >> 7, nl = tid & 127, n = bx * 128 + nl;
            float acc[16];
#pragma unroll
            for (int m = 0; m < 16; ++m) acc[m] = 0.f;
#pragma unroll 8
            for (int kk = kg * 256; kk < kg * 256 + 256; ++kk) { const float w = w_in[(size_t)kk * DIN + n]; const LAS f32x4* u4 = (const LAS f32x4*)(um + kk * 16);
#pragma unroll
                for (int q = 0; q < 4; ++q) { const f32x4 uv = u4[q]; acc[4 * q + 0] += w * uv.x; acc[4 * q + 1] += w * uv.y; acc[4 * q + 2] += w * uv.z; acc[4 * q + 3] += w * uv.w; } }
#pragma unroll
            for (int m = 0; m < 16; ++m) red[(kg * 16 + m) * 128 + nl] = acc[m];
            __syncthreads();
            for (int o = tid; o < 2048; o += 512) { const int m = o >> 7, n2 = o & 127;
                const float s = (red[(0 * 16 + m) * 128 + n2] + red[(1 * 16 + m) * 128 + n2]) + (red[(2 * 16 + m) * 128 + n2] + red[(3 * 16 + m) * 128 + n2]);
                P[(size_t)(MROWS + m) * DIN + bx * 128 + n2] = (bf16)f2bf(s); }
            __syncthreads();
        }
        if (!split || bx >= 24) {
        LAS float* scr = (LAS float*)(lds + wave * 16384);
        constexpr int I_IN = (DM / 64) * (DIN / 32), I_O = (DM / 64) * (DM / 32), I_GU = (DM / 64) * (2 * DFF / 32), I_D = (DFF / 64) * (DM / 32);
        constexpr int NITEMS = I_IN + I_O + I_GU + I_D;
        for (int it = gw; it < NITEMS; it += NGW) {
            int r = it;
            if (r < I_IN) { p0_transpose_item(w_in, DM, DIN, Win_t, scr, r, lane, 0, nullptr); continue; } r -= I_IN;
            if (r < I_O) { p0_transpose_item(w_out, DM, DM, Wo_t, scr, r, lane, 0, nullptr); continue; } r -= I_O;
            if (r < I_GU) { p0_transpose_item(w_gu, DM, 2 * DFF, Wgu_t, scr, r, lane, 1, ffn_g); continue; } r -= I_GU;
            p0_transpose_item(w_down, DFF, DM, Wd_t, scr, r, lane, 0, nullptr);
        }
        for (int i = gw * 64 + lane; i < 2 * 8 * 64 * 64; i += NGW * 64) {
            const int gt = i >> 15, hh = (i >> 12) & 7, j = (i >> 6) & 63, ii = i & 63;
            Wg_t[i] = (bf16)f2bf((gt ? w_ig : w_rg)[hh * 4096 + ii * 64 + j]); }
        for (int m = 2 * gw; m < MROWS; m += 2 * NGW) rms_rows2_to_bf16(x + (size_t)m * DM, mix_g, XN + (size_t)m * DM, lane);
        }
    }
    SEAM(0);
#ifdef EXTRA_SYNCS
    for (int q_ = 0; q_ < EXTRA_SYNCS; ++q_) GBAR();
#endif
    REP(1) if (IN(1) && !(SKIPMASK & 2)) { if (rep_) GBAR();
        pg8::Gemm g{XN, Win_t, MROWS, DIN, DM}; pg8::StaticOrder S; S.init(MROWS, DIN, G, bx);
        pg8::EpiP E{P, DIN};
        pg8::gemm_phase<pg8::EpiP, pg8::StaticOrder, true, true>(lds, g, S, E);
    }
    SEAM(1);
    REP(2) if (IN(2) && !(SKIPMASK & 4)) { if (rep_) GBAR();
        for (int it = bx; it < 256; it += G) {
            int wv = wave, ln = lane, td = tid; asm volatile("" : "+s"(wv), "+v"(ln), "+v"(td));
#ifndef NO_RG
            rg_scan(lds, P, Wg_t, conv_w, conv_b, b_rg, b_ig, lam, Aseg, Hseg, hmeta, HLOC, PAC, it >> 5, it & 31, false, wv, ln);
            if (it == 255) rg_scan(lds, P, Wg_t, conv_w, conv_b, b_rg, b_ig, lam, Aseg, Hseg, hmeta, HLOC, PAC, 0, 0, true, wv, ln);
#endif
            __syncthreads();
#ifndef NO_HG
            hg_run<false>(lds, P, hg_lb, hg_g, Sloc, Btot, Smeta, Y, it >> 5, (it >> 3) & 3, it & 7, false, td, wv, ln);
            __syncthreads();
            if (it < 4) { hg_run<false>(lds, P, hg_lb, hg_g, Sloc, Btot, Smeta, Y, 0, it, 0, true, td, wv, ln); __syncthreads(); }
#endif
        }
    }
    SEAM(2);
    REP(3) if (IN(3) && !(SKIPMASK & 8)) { if (rep_) GBAR();
        for (int it = bx; it < 256; it += G) {
            int wv = wave, ln = lane, td = tid; asm volatile("" : "+s"(wv), "+v"(ln), "+v"(td));
#ifndef NO_RG
            rg_final(lds, P, HLOC, PAC, Aseg, Hseg, hmeta, rg_g, Y, it >> 5, it & 31, td, wv, ln);
            __syncthreads();
#endif
#ifndef NO_HG
            hg_run<true>(lds, P, hg_lb, hg_g, Sloc, Btot, Smeta, Y, it >> 5, (it >> 3) & 3, it & 7, false, td, wv, ln);
            __syncthreads();
#endif
        }
    }
    SEAM(3);
    REP(4) if (IN(4) && !(SKIPMASK & 16)) { if (rep_) GBAR();
        pg8::Gemm g{Y, Wo_t, MROWS, DM, DM}; pg8::StaticOrder S; S.init(MROWS, DM, G, bx);
        pg8::EpiOut E{x, H1B, SSQ1};
        pg8::gemm_phase<pg8::EpiOut, pg8::StaticOrder, true, true>(lds, g, S, E);
    }
    SEAM(4);
    REP(5) if (IN(5) && !(SKIPMASK & 32)) { if (rep_) GBAR();
        pg8::Gemm g{H1B, Wgu_t, MROWS, 2 * DFF, DM}; pg8::StaticOrder S; S.init(MROWS, 2 * DFF, G, bx);
        pg8::EpiGU E{SSQ1, ACT};
        pg8::gemm_phase<pg8::EpiGU, pg8::StaticOrder, true, true>(lds, g, S, E);
    }
    SEAM(5);
    REP(6) if (IN(6) && !(SKIPMASK & 64)) { if (rep_) GBAR();
        pg8::Gemm g{ACT, Wd_t, MROWS, DM, DFF}; pg8::StaticOrder S; S.init(MROWS, DM, G, bx);
        pg8::EpiDown E{H1B, SSQ2};
        pg8::gemm_phase<pg8::EpiDown, pg8::StaticOrder, true, true>(lds, g, S, E);
    }
    SEAM(6);
    REP(7) if (IN(7) && !(SKIPMASK & 128)) { if (rep_) GBAR();
        const int gw = bx * 8 + wave, NGW = G * 8;
        for (int m = gw; m < MROWS; m += NGW) {
            const float sv = (lane < 16) ? SSQ2[(size_t)m * 16 + lane] : 0.f;
            const float rinv = rsqrtf(wave_sum(sv) * (1.f / DM) + EPS);
            const float* gp = fin_g;
#pragma unroll
            for (int j = 0; j < 2; ++j) { const int c0 = (64 * j + lane) * 8; const v4u hv = *(const v4u*)(H1B + (size_t)m * DM + c0); const f32x4 ga = *(const f32x4*)(gp + c0), gb = *(const f32x4*)(gp + c0 + 4);
                f32x4 oa = {bflo(hv.x) * rinv * ga.x, bfhi(hv.x) * rinv * ga.y, bflo(hv.y) * rinv * ga.z, bfhi(hv.y) * rinv * ga.w};
                f32x4 ob = {bflo(hv.z) * rinv * gb.x, bfhi(hv.z) * rinv * gb.y, bflo(hv.w) * rinv * gb.z, bfhi(hv.w) * rinv * gb.w};
                *(f32x4*)(out + (size_t)m * DM + c0) = oa; *(f32x4*)(out + (size_t)m * DM + c0 + 4) = ob; }
        }
    }
#undef IN
#undef SEAM
}

extern "C" void kernel_launch(void* const* d_in, const int* in_sizes, int n_in, void* d_out, int out_size, void* d_ws, size_t ws_size, hipStream_t stream) {
    static int grid = 0;
    if (grid == 0) {
        if (n_in != 19 || in_sizes[0] != MROWS * DM || out_size != MROWS * DM || ws_size < WS_END) { fprintf(stderr, "kernel_launch: unexpected shapes (n_in %d, in0 %d, out %d, ws %zu)\n", n_in, n_in > 0 ? in_sizes[0] : -1, out_size, ws_size); grid = -1; return; }
        int dev = 0, cus = 0, per_cu = 0;
        hipGetDevice(&dev); hipDeviceGetAttribute(&cus, hipDeviceAttributeMultiprocessorCount, dev);
        if (hipFuncSetAttribute((const void*)fwd_megakernel, hipFuncAttributeMaxDynamicSharedMemorySize, LDS_BYTES) != hipSuccess) { fprintf(stderr, "kernel_launch: hipFuncSetAttribute failed\n"); grid = -1; return; }
        if (hipOccupancyMaxActiveBlocksPerMultiprocessor(&per_cu, (const void*)fwd_megakernel, 512, LDS_BYTES) != hipSuccess || per_cu < 1) { fprintf(stderr, "kernel_launch: occupancy query gave %d\n", per_cu); per_cu = 1; }
        (void)hipGetLastError();
        grid = cus * per_cu;
        fprintf(stderr, "kernel_launch: grid %d (cus %d x %d)\n", grid, cus, per_cu);
    }
    if (grid < 0) return;
    Args a{};
    for (int i = 0; i < 19; ++i) a.in[i] = (const float*)d_in[i];
    a.out = (float*)d_out; a.ws = (unsigned char*)d_ws;
#if MK_N_LAUNCHES == 1
    if (hipMemsetAsync((char*)d_ws + WS_BAR, 0, XCD_BAR_WORDS * 4, stream) != hipSuccess) { fprintf(stderr, "kernel_launch: memset failed\n"); return; }
    a.ph_lo = 0; a.ph_hi = NPH;
    void* kargs[] = {&a};
    hipError_t e = hipLaunchCooperativeKernel((const void*)fwd_megakernel, dim3(grid), dim3(512), kargs, LDS_BYTES, stream);
    if (e != hipSuccess) fprintf(stderr, "kernel_launch: cooperative launch failed: %s (grid %d)\n", hipGetErrorString(e), grid);
#else
    for (int p = 0; p < NPH; ++p) { a.ph_lo = p; a.ph_hi = p + 1; hipLaunchKernelGGL(fwd_megakernel, dim3(grid), dim3(512), LDS_BYTES, stream, a); }
#endif
}
```
